# Optimizing an MI355X kernel written in HIP

```python
import math
import jax, jax.numpy as jnp
from jax import lax
import numpy as np

D_MODEL = 1024
BATCH = 2
SEQ = 8192
DEPTH = 2

N_META = 16
HEAD_DIM = 64
N_Q_HEADS = 16
N_KV_HEADS = 4
Q_PER_KV = N_Q_HEADS // N_KV_HEADS
D_ATTN = N_Q_HEADS * HEAD_DIM
D_KV = N_KV_HEADS * HEAD_DIM
WINDOW = 128
BLOCK = 128
ROPE_THETA = 10000.0
ATTN_SCALE = HEAD_DIM ** -0.5
NEG_INF = -1e30
D_SSM = D_MODEL // 2
SSM_GROUP = 16
N_SSM_GROUPS = D_SSM // SSM_GROUP
SSM_STATE = 64
DT_MIN = 1e-3
DT_MAX = 1e-1
D_FF = 4 * D_MODEL
RMS_EPS = 1e-6
D_IN = D_SSM + D_ATTN + 2 * D_KV + 2 * D_MODEL

kernel_name = "hybrid_s5_swa_sink_gated_block"


def rmsnorm(x, gain):
    xf = x.astype(jnp.float32)
    xf = xf * lax.rsqrt(jnp.mean(xf * xf, axis=-1, keepdims=True) + RMS_EPS)
    return (xf * gain.astype(jnp.float32)).astype(x.dtype)


def rotary(t, pos):
    inv_freq = 1.0 / (ROPE_THETA ** (jnp.arange(0, HEAD_DIM, 2, dtype=jnp.float32) / HEAD_DIM))
    ang = pos.astype(jnp.float32)[:, None] * inv_freq[None, :]
    ang = jnp.concatenate([ang, ang], axis=-1)[None, :, None, :]
    tf = t.astype(jnp.float32)
    half = HEAD_DIM // 2
    rot = jnp.concatenate([-tf[..., half:], tf[..., :half]], axis=-1)
    return (tf * jnp.cos(ang) + rot * jnp.sin(ang)).astype(t.dtype)


def s5_branch(u, a_re, a_im, log_dt, b_re, b_im, c_re, c_im, d_skip, w_glu, b_glu):
    bsz, seq_len, _ = u.shape
    f32 = jnp.float32
    uf = u.astype(f32).reshape(bsz, seq_len, N_SSM_GROUPS, SSM_GROUP)
    a = lax.complex(a_re.astype(f32), a_im.astype(f32))
    dt = jnp.exp(log_dt.astype(f32))[:, None]
    a_bar = jnp.exp(a * dt)
    b = lax.complex(b_re.astype(f32), b_im.astype(f32))
    b_bar = ((a_bar - 1.0) / a)[..., None] * b
    bu = jnp.einsum('blgc,gnc->blgn', uf.astype(jnp.complex64), b_bar)

    def combine(e1, e2):
        a1, s1 = e1
        a2, s2 = e2
        return a1 * a2, a2 * s1 + s2

    a_seq = jnp.broadcast_to(a_bar, bu.shape)
    _, states = lax.associative_scan(combine, (a_seq, bu), axis=1)
    c = lax.complex(c_re.astype(f32), c_im.astype(f32))
    y = jnp.einsum('blgn,gcn->blgc', states, c).real + d_skip.astype(f32) * uf
    y = y.reshape(bsz, seq_len, D_SSM)
    z = jax.nn.gelu(y)
    z = z * jax.nn.sigmoid(z @ w_glu.astype(f32) + b_glu.astype(f32))
    return z.astype(u.dtype)


def sliding_window_attention(q, k, v, sinks):
    bsz, seq_len = q.shape[0], q.shape[1]
    pad = (-seq_len) % BLOCK
    n_blk = (seq_len + pad) // BLOCK
    qb = jnp.pad(q, ((0, 0), (pad, 0), (0, 0), (0, 0))).reshape(
        bsz, n_blk, BLOCK, N_KV_HEADS, Q_PER_KV, HEAD_DIM)
    front = ((0, 0), (pad + BLOCK, 0), (0, 0), (0, 0))
    kb = jnp.pad(k, front).reshape(bsz, n_blk + 1, BLOCK, N_KV_HEADS, HEAD_DIM)
    vb = jnp.pad(v, front).reshape(bsz, n_blk + 1, BLOCK, N_KV_HEADS, HEAD_DIM)
    k_win = jnp.concatenate([kb[:, :-1], kb[:, 1:]], axis=2)
    v_win = jnp.concatenate([vb[:, :-1], vb[:, 1:]], axis=2)
    k_meta, v_meta = k[:, :N_META], v[:, :N_META]

    s_meta = jnp.einsum('bnqkgd,bskd->bnkgqs', qb, k_meta, preferred_element_type=jnp.float32)
    s_win = jnp.einsum('bnqkgd,bnskd->bnkgqs', qb, k_win, preferred_element_type=jnp.float32)
    s = jnp.concatenate([s_meta, s_win], axis=-1) * ATTN_SCALE

    q_idx = (jnp.arange(n_blk)[:, None] * BLOCK + jnp.arange(BLOCK)[None, :])[:, :, None]
    kw_idx = ((jnp.arange(n_blk)[:, None] - 1) * BLOCK + jnp.arange(2 * BLOCK)[None, :])[:, None, :]
    km_idx = (pad + jnp.arange(N_META))[None, None, :]
    win_ok = (kw_idx >= pad) & (kw_idx <= q_idx) & (q_idx - kw_idx < WINDOW)
    meta_ok = (km_idx <= q_idx) & (q_idx - km_idx >= WINDOW)
    ok = jnp.concatenate([jnp.broadcast_to(meta_ok, (n_blk, BLOCK, N_META)), win_ok], axis=-1)
    s = jnp.where(ok[None, :, None, None], s, NEG_INF)

    sink = sinks.astype(jnp.float32).reshape(N_KV_HEADS, Q_PER_KV)[None, None, :, :, None, None]
    m = jnp.maximum(jnp.max(s, axis=-1, keepdims=True), sink)
    p = jnp.exp(s - m)
    p = p / (jnp.sum(p, axis=-1, keepdims=True) + jnp.exp(sink - m))
    p = p.astype(v.dtype)
    o = (jnp.einsum('bnkgqs,bskd->bnqkgd', p[..., :N_META], v_meta)
         + jnp.einsum('bnkgqs,bnskd->bnqkgd', p[..., N_META:], v_win))
    return o.reshape(bsz, n_blk * BLOCK, D_ATTN)[:, pad:]


def hybrid_mixer(h, pos, w_in, a_re, a_im, log_dt, b_re, b_im, c_re, c_im, d_skip, w_glu, b_glu,
                 sinks, w_o_ssm, w_o_attn, w_out):
    bsz, seq_len, _ = h.shape
    proj = h @ w_in
    cuts = [D_SSM, D_SSM + D_ATTN, D_SSM + D_ATTN + D_KV, D_SSM + D_ATTN + 2 * D_KV,
            D_SSM + D_ATTN + 2 * D_KV + D_MODEL]
    u, q, k, v, g_ssm, g_attn = jnp.split(proj, cuts, axis=-1)
    y_ssm = s5_branch(u, a_re, a_im, log_dt, b_re, b_im, c_re, c_im, d_skip, w_glu, b_glu)
    q = rotary(q.reshape(bsz, seq_len, N_Q_HEADS, HEAD_DIM), pos)
    k = rotary(k.reshape(bsz, seq_len, N_KV_HEADS, HEAD_DIM), pos)
    v = v.reshape(bsz, seq_len, N_KV_HEADS, HEAD_DIM)
    y_attn = sliding_window_attention(q, k, v, sinks)
    merged = jax.nn.sigmoid(g_ssm) * (y_ssm @ w_o_ssm) + jax.nn.sigmoid(g_attn) * (y_attn @ w_o_attn)
    return merged @ w_out


def setup_inputs(seed: int = 0) -> dict:
    key = jax.random.key(seed)
    ks = jax.random.split(key, 24)
    f32 = jnp.float32

    def nrm(k, shape, std):
        return std * jax.random.normal(k, shape, f32)

    G, N, C = N_SSM_GROUPS, SSM_STATE, SSM_GROUP
    a_im_init = math.pi * jnp.arange(N, dtype=f32)[None, None, :]
    return {
        "x": nrm(ks[0], (BATCH, SEQ, D_MODEL), 1.0),
        "meta_tokens": nrm(ks[1], (N_META, D_MODEL), 1.0),
        "norm_mix_pre": 1.0 + nrm(ks[2], (DEPTH, D_MODEL), 0.02),
        "norm_mix_post": 1.0 + nrm(ks[3], (DEPTH, D_MODEL), 0.02),
        "norm_mlp_pre": 1.0 + nrm(ks[4], (DEPTH, D_MODEL), 0.02),
        "norm_mlp_post": 1.0 + nrm(ks[5], (DEPTH, D_MODEL), 0.02),
        "w_in": nrm(ks[6], (DEPTH, D_MODEL, D_IN), D_MODEL ** -0.5),
        "ssm_a_re": -0.5 + nrm(ks[7], (DEPTH, G, N), 0.01),
        "ssm_a_im": a_im_init + nrm(ks[8], (DEPTH, G, N), 0.01),
        "ssm_log_dt": jax.random.uniform(ks[9], (DEPTH, G), f32, math.log(DT_MIN), math.log(DT_MAX)),
        "ssm_b_re": nrm(ks[10], (DEPTH, G, N, C), (2.0 * C) ** -0.5),
        "ssm_b_im": nrm(ks[11], (DEPTH, G, N, C), (2.0 * C) ** -0.5),
        "ssm_c_re": nrm(ks[12], (DEPTH, G, C, N), 0.5),
        "ssm_c_im": nrm(ks[13], (DEPTH, G, C, N), 0.5),
        "ssm_d": nrm(ks[14], (DEPTH, G, C), 1.0),
        "w_glu": nrm(ks[15], (DEPTH, D_SSM, D_SSM), D_SSM ** -0.5),
        "b_glu": nrm(ks[16], (DEPTH, D_SSM), 0.01),
        "attn_sinks": nrm(ks[17], (DEPTH, N_Q_HEADS), 0.5),
        "w_o_ssm": nrm(ks[18], (DEPTH, D_SSM, D_MODEL), D_SSM ** -0.5),
        "w_o_attn": nrm(ks[19], (DEPTH, D_ATTN, D_MODEL), D_ATTN ** -0.5),
        "w_out": nrm(ks[20], (DEPTH, D_MODEL, D_MODEL), D_MODEL ** -0.5),
        "w_up": nrm(ks[21], (DEPTH, D_MODEL, D_FF), D_MODEL ** -0.5),
        "w_down": nrm(ks[22], (DEPTH, D_FF, D_MODEL), D_FF ** -0.5),
    }


def reference(x, meta_tokens, norm_mix_pre, norm_mix_post, norm_mlp_pre, norm_mlp_post, w_in,
              ssm_a_re, ssm_a_im, ssm_log_dt, ssm_b_re, ssm_b_im, ssm_c_re, ssm_c_im, ssm_d,
              w_glu, b_glu, attn_sinks, w_o_ssm, w_o_attn, w_out, w_up, w_down):
    bsz = x.shape[0]
    meta = jnp.broadcast_to(meta_tokens[None].astype(x.dtype), (bsz, N_META, D_MODEL))
    hres = jnp.concatenate([meta, x], axis=1)
    pos = jnp.arange(hres.shape[1], dtype=jnp.int32)
    for l in range(DEPTH):
        h = rmsnorm(hres, norm_mix_pre[l])
        mix = hybrid_mixer(h, pos, w_in[l], ssm_a_re[l], ssm_a_im[l], ssm_log_dt[l], ssm_b_re[l],
                           ssm_b_im[l], ssm_c_re[l], ssm_c_im[l], ssm_d[l], w_glu[l], b_glu[l],
                           attn_sinks[l], w_o_ssm[l], w_o_attn[l], w_out[l])
        hres = hres + rmsnorm(mix, norm_mix_post[l])
        h = rmsnorm(hres, norm_mlp_pre[l])
        ff = jnp.square(jax.nn.relu(h @ w_up[l])) @ w_down[l]
        hres = hres + rmsnorm(ff, norm_mlp_post[l])
    return hres[:, N_META:]
```

```cpp
#include <hip/hip_runtime.h>
#include <cstdio>
#include <cstdint>

#define N_LAUNCH_SPLIT 0
#define PROBE_BUF WS_G2
#define PROBE_LD 1024
#ifndef CHECK_MODE
#define CHECK_MODE 0
#endif

#define GAS __attribute__((address_space(1)))
#define LAS __attribute__((address_space(3)))
typedef unsigned short bf16_t;
typedef short bf16x8 __attribute__((ext_vector_type(8)));
typedef short s16x4 __attribute__((ext_vector_type(4)));
typedef float f32x2 __attribute__((ext_vector_type(2)));
typedef float f32x4 __attribute__((ext_vector_type(4)));
typedef float f32x16 __attribute__((ext_vector_type(16)));
typedef unsigned u32x2 __attribute__((ext_vector_type(2)));
typedef unsigned u32x4 __attribute__((ext_vector_type(4)));

constexpr int NB = 2, SEQ = 8192, DM = 1024, NMETA = 16, DEPTH = 2;
constexpr int MMAIN = NB * SEQ;
constexpr int MR = 16640;
constexpr int META0 = MMAIN;
constexpr int DIN = 4096, DSSM = 512, DATT = 1024, DKV = 256, DFF = 4096;
constexpr int NQH = 16, NKVH = 4, HD = 64;
constexpr int NGRP = 32, NST = 64, GCH = 16;
constexpr int TCH = 32;
constexpr int NCHUNK = MMAIN / TCH;
constexpr int CRS = NCHUNK + 1;
constexpr int AGLD = 640;
constexpr float RMS_EPS = 1e-6f;
constexpr float QSCALE = 0.125f * 1.4426950408889634f;
constexpr float LOG2E = 1.4426950408889634f;

constexpr size_t MiB = 1u << 20;
constexpr size_t WS_CTL = 0, CTL_ZERO_BYTES = 1 * MiB;
constexpr size_t WS_COS = 1 * MiB, WS_SIN = 2 * MiB + 256 * 1024;
constexpr size_t WS_A32 = 3 * MiB + 512 * 1024;
constexpr size_t WS_XMETA = 3 * MiB + 768 * 1024;
constexpr size_t WS_KHM = 3 * MiB + 896 * 1024;
constexpr size_t WS_VTM = 3 * MiB + 928 * 1024;
constexpr size_t WS_CHK = 4 * MiB;
constexpr size_t WS_WIN = 6 * MiB;
constexpr size_t WS_WGLU = 14 * MiB;
constexpr size_t WS_WOS = 14 * MiB + 512 * 1024;
constexpr size_t WS_WOA = 16 * MiB + 512 * 1024;
constexpr size_t WS_WOUT = 18 * MiB + 512 * 1024;
constexpr size_t WS_WUP = 20 * MiB + 512 * 1024;
constexpr size_t WS_WDN = 28 * MiB + 512 * 1024;
constexpr size_t WS_H = 37 * MiB;
constexpr size_t WS_BTY = 70 * MiB;
constexpr size_t WS_BTE = 90 * MiB;
constexpr size_t WS_AG = 94 * MiB + 512 * 1024;
constexpr size_t WS_E = 115 * MiB;
constexpr size_t WS_KH = 123 * MiB + 512 * 1024;
constexpr size_t WS_VT = 131 * MiB + 512 * 1024;
constexpr size_t WS_Q = 139 * MiB + 512 * 1024;
constexpr size_t WS_G1 = 172 * MiB;
constexpr size_t WS_G2 = 204 * MiB + 512 * 1024;
constexpr size_t WS_END = 237 * MiB;
constexpr size_t WS_MERGED = WS_AG;
constexpr size_t WS_MIX = WS_G1;
constexpr size_t WS_FF = WS_BTY;
static_assert(WS_FF + (size_t)MR * DFF * 2 <= WS_END, "ff overlay");
static_assert(WS_AG + ((size_t)NGRP * CRS + 255) * AGLD * 2 <= WS_E, "AG");
static_assert(WS_E + (size_t)NGRP * CRS * 128 * 4 <= WS_KH, "E");
static_assert(WS_MERGED + (size_t)MR * DM * 2 <= WS_VT, "merged overlay");
static_assert(WS_H + (size_t)MR * DM * 2 <= WS_BTY, "H");
static_assert(WS_BTE + (size_t)(NGRP * 128 + 128) * 512 * 2 <= WS_AG, "BTE");

constexpr int CW_BAR = 4096;
constexpr int CW_CHK = 1024;

#define RLX_AGENT __ATOMIC_RELAXED, __HIP_MEMORY_SCOPE_AGENT
__device__ __forceinline__ float bf2f(bf16_t v) { return __uint_as_float((unsigned)v << 16); }
__device__ __forceinline__ unsigned f2bf(float f) { unsigned u = __float_as_uint(f); return (u + 0x7fffu + ((u >> 16) & 1u)) >> 16; }
typedef __bf16 bf16x2_t __attribute__((ext_vector_type(2)));
__device__ __forceinline__ unsigned cvt_pk_bf16(float lo, float hi) { const f32x2 v = {lo, hi}; const bf16x2_t b = __builtin_convertvector(v, bf16x2_t); return __builtin_bit_cast(unsigned, b); }
__device__ __forceinline__ float sigmoidf_(float x) { return __builtin_amdgcn_rcpf(1.f + __builtin_amdgcn_exp2f(-x * LOG2E)); }
__device__ __forceinline__ float gelu_tanh(float y) { const float k = 0.7978845608028654f * (y + 0.044715f * y * y * y); return y * __builtin_amdgcn_rcpf(1.f + __builtin_amdgcn_exp2f(-2.f * LOG2E * k)); }
__device__ __forceinline__ float wave_sum(float v) {
#pragma unroll
    for (int o = 1; o < 64; o <<= 1) v += __shfl_xor(v, o);
    return v;
}
__host__ __device__ __forceinline__ int qk_phys(int d) { return 32 * ((d >> 4) & 1) + 8 * ((d >> 2) & 3) + 4 * (d >> 5) + (d & 3); }

#define XB_TMO      128
#define XB_XCNT(j)  (256  + 64 * (j))
#define XB_XSUB(j)  (1280 + 64 * (j))
#define XB_XGEN(j)  (2304 + 64 * (j))
#define XB_TOP      3328
#define XB_TOPGEN   3392
#define XCD_BAR_WORDS 3456
#define XB_SPIN_CAP (1u << 20)
__device__ __forceinline__ unsigned xb_ld(unsigned* p)              { return __hip_atomic_load(p, __ATOMIC_RELAXED, __HIP_MEMORY_SCOPE_AGENT); }
__device__ __forceinline__ unsigned xb_add(unsigned* p, unsigned v) { return __hip_atomic_fetch_add(p, v, __ATOMIC_RELAXED, __HIP_MEMORY_SCOPE_AGENT); }
__device__ __forceinline__ unsigned xb_xcc_id() { return (unsigned)__builtin_amdgcn_s_getreg((3 << 11) | 20) & 0xFu; }
#define XB_SPIN(cond, bar) do { unsigned _sp = 0; while (cond) { __builtin_amdgcn_s_sleep(1); \
    if ((++_sp & 255u) == 0u) { if (xb_ld(&(bar)[XB_TMO])) break; if (_sp > XB_SPIN_CAP) { atomicAdd(&(bar)[XB_TMO], 1u); break; } } } } while (0)
struct XcdBarrier { unsigned* bar; unsigned x; volatile LAS unsigned* st; };
__device__ __forceinline__ XcdBarrier xcd_barrier_post(unsigned* bar, volatile LAS unsigned* st) {
    XcdBarrier b; b.bar = bar; b.x = xb_xcc_id(); b.st = st;
    if (threadIdx.x == 0) (void)xb_add(&bar[XB_XCNT(b.x)], 1u);
    return b;
}
__device__ __forceinline__ void xcd_barrier_complete(unsigned* bar, unsigned x, unsigned& nloc, unsigned& nx) {
    const unsigned G = gridDim.x * gridDim.y * gridDim.z;
    unsigned sum, cnt, mine, sp = 0u;
    for (;;) {
        sum = 0u; cnt = 0u; mine = 0u;
#pragma unroll
        for (unsigned j = 0; j < 16; ++j) { const unsigned c = xb_ld(&bar[XB_XCNT(j)]); sum += c; cnt += (c > 0u) ? 1u : 0u; mine = (j == x) ? c : mine; }
        if (sum == G) break;
        __builtin_amdgcn_s_sleep(1);
        if ((++sp & 255u) == 0u) { if (xb_ld(&bar[XB_TMO])) break; if (sp > XB_SPIN_CAP) { atomicAdd(&bar[XB_TMO], 1u); break; } }
    }
    nloc = mine > 0u ? mine : 1u; nx = cnt > 0u ? cnt : 1u;
}
__device__ __forceinline__ void xcd_barrier(const XcdBarrier& b) {
    asm volatile("s_waitcnt vmcnt(0)" ::: "memory");
    __syncthreads();
    if (threadIdx.x == 0) {
        unsigned* bar = b.bar;
        __builtin_amdgcn_s_waitcnt(0);
        unsigned nloc = b.st[0], nx = b.st[1];
        if (nloc == 0u) { xcd_barrier_complete(bar, b.x, nloc, nx); b.st[0] = nloc; b.st[1] = nx; }
        const unsigned old = xb_add(&bar[XB_XSUB(b.x)], 1u);
        const unsigned gen = old / nloc;
        if (old + 1u == (gen + 1u) * nloc) {
            __builtin_amdgcn_fence(__ATOMIC_RELEASE, "agent");
            asm volatile("s_waitcnt vmcnt(0)" ::: "memory");
            const unsigned og = xb_add(&bar[XB_TOP], 1u);
            const unsigned tg = og / nx;
            if (og + 1u == (tg + 1u) * nx) xb_add(&bar[XB_TOPGEN], 1u);
            else XB_SPIN(xb_ld(&bar[XB_TOPGEN]) == tg, bar);
            __builtin_amdgcn_fence(__ATOMIC_ACQUIRE, "agent");
            xb_add(&bar[XB_XGEN(b.x)], 1u);
            asm volatile("s_waitcnt vmcnt(0)" ::: "memory");
        } else {
            XB_SPIN(xb_ld(&bar[XB_XGEN(b.x)]) == gen, bar);
            __builtin_amdgcn_fence(__ATOMIC_ACQUIRE, "agent");
            asm volatile("s_waitcnt vmcnt(0)" ::: "memory");
        }
    }
    __syncthreads();
}

namespace eng {
constexpr int BM = 256, BK = 64, HALF = 128, HTB = HALF * BK * 2, STAGE_BYTES = 8 * HTB, NXCD = 8, WGM = 8;
__host__ __device__ __forceinline__ int lds_byte(int r, int c) { const int st = (r >> 4) * 2 + (c >> 5), rr = r & 15, cc = c & 31, ob = rr * 64 + cc * 2; return st * 1024 + (ob ^ (((ob >> 9) & 1) << 5)); }
__host__ __device__ __forceinline__ void stage_rc(int b, int& R, int& C) { const int st = b / 1024, sb = b % 1024, swz = sb ^ (((sb >> 9) & 1) << 5); R = (st >> 1) * 16 + swz / 64; C = (st & 1) * 32 + (swz % 64) / 2; }
__host__ __device__ __forceinline__ int perm32(int rho) { const int n = rho >> 4, i = rho & 15; return 8 * (i >> 2) + 4 * n + (i & 3); }

struct Unit { const char* A; const char* B; int nt, pm, pn, aux; };

template <class Epi, class Sched>
__device__ __forceinline__ void gemm_phase(LAS unsigned char* lds, const int tid, const int lda, const int ldb, const Sched& S, const Epi& E) {
    const int wid = __builtin_amdgcn_readfirstlane(tid >> 6), lane = tid & 63, wr = wid >> 2, wc = wid & 3, fr = lane & 15, fq = lane >> 4;
    unsigned voffA[2], voffB[2];
#pragma unroll
    for (int i = 0; i < 2; ++i) { int R, C; stage_rc(tid * 16 + i * 8192, R, C); const int Rb = (R & ~31) + perm32(R & 31);
        voffA[i] = (unsigned)(R * lda + C * 2); voffB[i] = (unsigned)(Rb * ldb + C * 2); }
    const size_t kstep = (size_t)(BK * 2);
    const size_t hstepA = (size_t)HALF * lda, hstepB = (size_t)HALF * ldb;
    const unsigned ldsw = (unsigned)wid * 1024u;
    const int aoff = lds_byte(wr * 64 + fr, fq * 8), boff = lds_byte(wc * 32 + fr, fq * 8);
#define PG8_SA(b, h) (((b) * 2 + (h)) * HTB)
#define PG8_SB(b, h) ((4 + (b) * 2 + (h)) * HTB)
#define PG8_STAGE(bufoff, gbase, voff) do { _Pragma("unroll") for (int _i = 0; _i < 2; ++_i) \
        __builtin_amdgcn_global_load_lds((const unsigned*)((const char*)(gbase) + (voff)[_i]), (LAS unsigned*)(lds + (bufoff) + ldsw + _i * 8192), 16, 0, 0); } while (0)
#define PG8_LDA(dst, b, h) do { _Pragma("unroll") for (int m = 0; m < 4; ++m) _Pragma("unroll") for (int k = 0; k < 2; ++k) dst[m][k] = *(const LAS bf16x8*)(lds + PG8_SA(b, h) + aoff + m * 2048 + k * 1024); } while (0)
#define PG8_LDB(dst, b, h) do { _Pragma("unroll") for (int n = 0; n < 2; ++n) _Pragma("unroll") for (int k = 0; k < 2; ++k) dst[n][k] = *(const LAS bf16x8*)(lds + PG8_SB(b, h) + boff + n * 2048 + k * 1024); } while (0)
#define PG8_MMA(ai, bj, At, Bt) do { __builtin_amdgcn_s_setprio(1); _Pragma("unroll") for (int m = 0; m < 4; ++m) _Pragma("unroll") for (int n = 0; n < 2; ++n) _Pragma("unroll") for (int k = 0; k < 2; ++k) \
        acc[ai][bj][m][n] = __builtin_amdgcn_mfma_f32_16x16x32_bf16(Bt[n][k], At[m][k], acc[ai][bj][m][n], 0, 0, 0); __builtin_amdgcn_s_setprio(0); } while (0)
#define PG8_WAIT_V(n) asm volatile("s_waitcnt vmcnt(" #n ")" ::: "memory")
#define PG8_WAIT_L(n) asm volatile("s_waitcnt lgkmcnt(" #n ")" ::: "memory")
#define PG8_BAR __builtin_amdgcn_s_barrier()
#define PG8_SCHED __builtin_amdgcn_sched_barrier(0)
    Unit cur, nxt; int ui = 0;
    if (!S.next(0, cur)) return;
    f32x4 acc[2][2][4][2];
#pragma unroll
    for (int a = 0; a < 2; ++a)
#pragma unroll
        for (int b = 0; b < 2; ++b)
#pragma unroll
            for (int m = 0; m < 4; ++m)
#pragma unroll
                for (int n = 0; n < 2; ++n) acc[a][b][m][n] = (f32x4){0.f, 0.f, 0.f, 0.f};
    bf16x8 At[4][2], B0[2][2], B1[2][2];
    const char* cA = cur.A; const char* cB = cur.B;
    PG8_STAGE(PG8_SB(0, 0), cB, voffB); PG8_STAGE(PG8_SB(0, 1), cB + hstepB, voffB); PG8_STAGE(PG8_SA(0, 0), cA, voffA); PG8_STAGE(PG8_SA(0, 1), cA + hstepA, voffA);
    if (wr == 1) PG8_BAR;
    PG8_WAIT_V(2); PG8_BAR;
    PG8_STAGE(PG8_SB(1, 0), cB + kstep, voffB); PG8_STAGE(PG8_SA(1, 0), cA + kstep, voffA); PG8_STAGE(PG8_SB(1, 1), cB + hstepB + kstep, voffB);
    PG8_WAIT_V(6); PG8_BAR;
    for (;;) {
        const bool has_next = S.next(ui + 1, nxt);
        const char* nA = has_next ? nxt.A : cA; const char* nB = has_next ? nxt.B : cB;
        const int nt = cur.nt;
        for (int t = 0; t < nt; t += 2) {
            const bool last = (t == nt - 2);
            const char* a1 = cA + (size_t)(t + 1) * kstep;
            const char* a2 = last ? nA : cA + (size_t)(t + 2) * kstep; const char* b2 = last ? nB : cB + (size_t)(t + 2) * kstep;
            const char* a3 = a2 + kstep; const char* b3 = b2 + kstep;
            PG8_LDB(B0, 0, 0); PG8_LDB(B1, 0, 1); PG8_SCHED; PG8_LDA(At, 0, 0); PG8_STAGE(PG8_SA(1, 1), a1 + hstepA, voffA);
            PG8_WAIT_V(8); PG8_WAIT_L(0); PG8_BAR; PG8_MMA(0, 0, At, B0); PG8_MMA(0, 1, At, B1); PG8_BAR; PG8_SCHED;
            PG8_LDA(At, 0, 1); PG8_STAGE(PG8_SB(0, 0), b2, voffB); PG8_STAGE(PG8_SB(0, 1), b2 + hstepB, voffB); PG8_STAGE(PG8_SA(0, 0), a2, voffA);
            PG8_WAIT_V(8); PG8_WAIT_L(0); PG8_BAR; PG8_MMA(1, 0, At, B0); PG8_MMA(1, 1, At, B1); PG8_BAR; PG8_SCHED;
            PG8_LDB(B0, 1, 0); PG8_LDB(B1, 1, 1); PG8_SCHED; PG8_LDA(At, 1, 0); PG8_STAGE(PG8_SA(0, 1), a2 + hstepA, voffA);
            PG8_WAIT_V(8); PG8_WAIT_L(0); PG8_BAR; PG8_MMA(0, 0, At, B0); PG8_MMA(0, 1, At, B1); PG8_BAR; PG8_SCHED;
            PG8_LDA(At, 1, 1); PG8_STAGE(PG8_SB(1, 0), b3, voffB); PG8_STAGE(PG8_SB(1, 1), b3 + hstepB, voffB); PG8_STAGE(PG8_SA(1, 0), a3, voffA);
            PG8_WAIT_V(8); PG8_WAIT_L(0); PG8_BAR; PG8_MMA(1, 0, At, B0); PG8_MMA(1, 1, At, B1); PG8_BAR; PG8_SCHED;
        }
        if (wr == 0) PG8_BAR;
        const bool keep = E(acc, cur, wr, wc, fr, fq);
        if (!has_next) break;
        if (!keep) {
#pragma unroll
        for (int a = 0; a < 2; ++a)
#pragma unroll
            for (int b = 0; b < 2; ++b)
#pragma unroll
                for (int m = 0; m < 4; ++m)
#pragma unroll
                    for (int n = 0; n < 2; ++n) acc[a][b][m][n] = (f32x4){0.f, 0.f, 0.f, 0.f};
        }
        cur = nxt; cA = nA; cB = nB; ++ui;
        if (wr == 1) PG8_BAR;
    }
    PG8_WAIT_V(0);
    PG8_BAR;
#undef PG8_SA
#undef PG8_SB
#undef PG8_STAGE
#undef PG8_LDA
#undef PG8_LDB
#undef PG8_MMA
#undef PG8_WAIT_V
#undef PG8_WAIT_L
#undef PG8_BAR
#undef PG8_SCHED
}

struct TileSched {
    const char* A; const char* B; int lda, ldb, nt, nM, nN, nwg, G, c;
    __device__ __forceinline__ void init(const void* A_, const void* B_, int lda_, int ldb_, int K, int M, int N, int G_, int c_) {
        A = (const char*)A_; B = (const char*)B_; lda = lda_; ldb = ldb_; nt = K / BK; nM = M / BM; nN = N / BM; nwg = nM * nN; G = G_; c = c_; }
    __device__ __forceinline__ bool next(int i, Unit& u) const {
        const long L = (long)i * G + c; if (L >= nwg) return false;
        int wgid = (int)L; { const int q = nwg / NXCD, r = nwg % NXCD, xcd = wgid % NXCD, off = wgid / NXCD; wgid = (xcd < r ? xcd * (q + 1) : r * (q + 1) + (xcd - r) * q) + off; }
        const int nig = WGM * nN, gid = wgid / nig, fm = gid * WGM, gsz = (nM - fm) < WGM ? (nM - fm) : WGM;
        u.pm = fm + ((wgid % nig) % gsz); u.pn = (wgid % nig) / gsz; u.nt = nt; u.aux = 0;
        u.A = A + (size_t)u.pm * BM * lda; u.B = B + (size_t)u.pn * BM * ldb; return true;
    }
};
}

struct Params { const float* in[23]; float* out; unsigned char* ws; int ph_lo, ph_hi; };
enum { I_X = 0, I_META, I_NMIXPRE, I_NMIXPOST, I_NMLPPRE, I_NMLPPOST, I_WIN, I_ARE, I_AIM, I_LOGDT, I_BRE, I_BIM, I_CRE, I_CIM, I_SSMD, I_WGLU, I_BGLU, I_SINKS, I_WOS, I_WOA, I_WOUT, I_WUP, I_WDN };

constexpr int NWAVES = 8, NTHREADS = 512;
constexpr int RING_BYTES = 131072, LDSCTL_OFF = RING_BYTES, LDS_BYTES = 147456;

#define CAS __attribute__((address_space(4)))
typedef const CAS Params* ParamsPtr;
struct Ctx {
    LAS unsigned char* lds; int tid, lane, wave, vcu, G, bx;
    ParamsPtr p; unsigned char* ws;
};

__device__ __forceinline__ u32x4 pack8(const f32x4 a, const f32x4 b) { u32x4 w; w.x = cvt_pk_bf16(a[0], a[1]); w.y = cvt_pk_bf16(a[2], a[3]); w.z = cvt_pk_bf16(b[0], b[1]); w.w = cvt_pk_bf16(b[2], b[3]); return w; }
__device__ __forceinline__ void unpack8(const u32x4 w, f32x4& a, f32x4& b) {
    a[0] = __uint_as_float(w.x << 16); a[1] = __uint_as_float(w.x & 0xffff0000u); a[2] = __uint_as_float(w.y << 16); a[3] = __uint_as_float(w.y & 0xffff0000u);
    b[0] = __uint_as_float(w.z << 16); b[1] = __uint_as_float(w.z & 0xffff0000u); b[2] = __uint_as_float(w.w << 16); b[3] = __uint_as_float(w.w & 0xffff0000u); }

template <int ACT> struct EpiStore {
    bf16_t* O; int ldc;
    __device__ __forceinline__ bool operator()(f32x4 (&acc)[2][2][4][2], const eng::Unit& u, int wr, int wc, int fr, int fq) const {
        asm volatile("" : "+v"(fr), "+v"(fq));
        const int row0 = u.pm * 256 + wr * 64 + fr, col0 = u.pn * 256 + wc * 32 + 8 * fq;
#pragma unroll
        for (int ai = 0; ai < 2; ++ai)
#pragma unroll
            for (int m = 0; m < 4; ++m) { bf16_t* rowp = O + (size_t)(row0 + ai * 128 + m * 16) * ldc + col0;
#pragma unroll
                for (int bj = 0; bj < 2; ++bj) { f32x4 v0 = acc[ai][bj][m][0], v1 = acc[ai][bj][m][1];
                    if (ACT == 1) {
#pragma unroll
                        for (int i = 0; i < 4; ++i) { const float a = fmaxf(v0[i], 0.f), b = fmaxf(v1[i], 0.f); v0[i] = a * a; v1[i] = b * b; } }
                    *(u32x4*)(rowp + bj * 128) = pack8(v0, v1); } }
        return false;
    }
};

struct EpiWin {
    bf16_t *AG, *Q, *KH, *VT, *KHM, *VTM, *G1, *G2; const float *cosT, *sinT;
    __device__ __forceinline__ bool operator()(f32x4 (&acc)[2][2][4][2], const eng::Unit& u, int wr, int wc, int fr, int fq) const {
        asm volatile("" : "+v"(fr), "+v"(fq));
        const int pn = u.pn;
#pragma unroll
        for (int ai = 0; ai < 2; ++ai)
#pragma unroll
            for (int m = 0; m < 4; ++m) {
                const int row = u.pm * 256 + ai * 128 + wr * 64 + m * 16 + fr;
                const bool is_main = row < MMAIN, is_meta = (row >= META0) && (row < META0 + NMETA);
                const int b = row >> 13, t = row & (SEQ - 1), mi = row - META0;
                const int pos = is_main ? (t + NMETA) : (is_meta ? mi : 0);
#pragma unroll
                for (int bj = 0; bj < 2; ++bj) {
                    f32x4 v0 = acc[ai][bj][m][0], v1 = acc[ai][bj][m][1];
                    const int cl = bj * 128 + wc * 32 + 8 * fq;
                    if (pn < 2) {
                        const int j = pn * 256 + cl, g = j >> 4, c0 = j & 15;
                        if (is_main || is_meta) {
                            const int cr = is_main ? (row >> 5) : NCHUNK, tt = is_main ? (row & 31) : (16 + mi);
                            *(u32x4*)(AG + ((size_t)g * CRS + cr) * AGLD + 128 + tt * 16 + c0) = pack8(v0, v1); }
                    } else if (pn < 7) {
                        const int jf = 16 * (wc & 1) + 4 * fq;
                        const f32x4 cs = *(const f32x4*)(cosT + pos * 32 + jf), sn = *(const f32x4*)(sinT + pos * 32 + jf);
                        f32x4 o0 = v0 * cs - v1 * sn, o1 = v1 * cs + v0 * sn;
                        if (pn < 6) { o0 = o0 * QSCALE; o1 = o1 * QSCALE; *(u32x4*)(Q + (size_t)row * DM + (pn - 2) * 256 + cl) = pack8(o0, o1); }
                        else { const int kvh = cl >> 6, p = cl & 63;
                            if (is_main) *(u32x4*)(KH + ((size_t)(b * NKVH + kvh) * SEQ + t) * HD + p) = pack8(o0, o1);
                            else if (is_meta) *(u32x4*)(KHM + (kvh * NMETA + mi) * HD + p) = pack8(o0, o1); }
                    } else if (pn == 7) {
                        const int kvh = cl >> 6, d0 = cl & 63; const u32x4 w = pack8(v0, v1);
                        const unsigned ww[4] = {w.x, w.y, w.z, w.w};
                        if (is_main) { bf16_t* vp = VT + ((size_t)(b * NKVH + kvh) * HD + d0) * SEQ + t;
#pragma unroll
                            for (int i = 0; i < 8; ++i) vp[(size_t)i * SEQ] = (bf16_t)((ww[i >> 1] >> ((i & 1) * 16)) & 0xffffu); }
                        else if (is_meta) { bf16_t* vp = VTM + (kvh * HD + d0) * NMETA + mi;
#pragma unroll
                            for (int i = 0; i < 8; ++i) vp[i * NMETA] = (bf16_t)((ww[i >> 1] >> ((i & 1) * 16)) & 0xffffu); }
                    } else {
#pragma unroll
                        for (int i = 0; i < 4; ++i) { v0[i] = sigmoidf_(v0[i]); v1[i] = sigmoidf_(v1[i]); }
                        bf16_t* gp = (pn < 12) ? (G1 + (size_t)row * DM + (pn - 8) * 256 + cl) : (G2 + (size_t)row * DM + (pn - 12) * 256 + cl);
                        *(u32x4*)gp = pack8(v0, v1);
                    }
                }
            }
        return false;
    }
};

struct EpiSsdE {
    float* E;
    __device__ __forceinline__ bool operator()(f32x4 (&acc)[2][2][4][2], const eng::Unit& u, int wr, int wc, int fr, int fq) const {
        asm volatile("" : "+v"(fr), "+v"(fq));
        const int g = u.aux;
#pragma unroll
        for (int ai = 0; ai < 2; ++ai)
#pragma unroll
            for (int m = 0; m < 4; ++m) { const int cr = u.pm * 256 + ai * 128 + wr * 64 + m * 16 + fr;
                if (cr < CRS) { float* ep = E + ((size_t)g * CRS + cr) * 128 + wc * 32 + 8 * fq; *(f32x4*)ep = acc[ai][0][m][0]; *(f32x4*)(ep + 4) = acc[ai][0][m][1]; } }
        return false;
    }
};
struct EpiSsdY {
    bf16_t* Y;
    __device__ __forceinline__ bool operator()(f32x4 (&acc)[2][2][4][2], const eng::Unit& u, int wr, int wc, int fr, int fq) const {
        asm volatile("" : "+v"(fr), "+v"(fq));
        const int g = u.aux;
#pragma unroll
        for (int ai = 0; ai < 2; ++ai)
#pragma unroll
            for (int m = 0; m < 4; ++m) { const int cr = u.pm * 256 + ai * 128 + wr * 64 + m * 16 + fr;
#pragma unroll
                for (int bj = 0; bj < 2; ++bj) {
                    const int t = 16 * u.pn + 8 * bj + 2 * wc + (fq >> 1), c0 = 8 * (fq & 1);
                    int row = -1;
                    if (cr < NCHUNK) row = cr * TCH + t; else if (cr == NCHUNK && t >= 16) row = META0 + t - 16;
                    if (row >= 0) { f32x4 v0 = acc[ai][bj][m][0], v1 = acc[ai][bj][m][1];
#pragma unroll
                        for (int i = 0; i < 4; ++i) { v0[i] = gelu_tanh(v0[i]); v1[i] = gelu_tanh(v1[i]); }
                        *(u32x4*)(Y + (size_t)row * DM + 512 + g * 16 + c0) = pack8(v0, v1); } } }
        return false;
    }
};
struct EpiGlu {
    bf16_t* Y; const float* bias;
    __device__ __forceinline__ bool operator()(f32x4 (&acc)[2][2][4][2], const eng::Unit& u, int wr, int wc, int fr, int fq) const {
        asm volatile("" : "+v"(fr), "+v"(fq));
#pragma unroll
        for (int bj = 0; bj < 2; ++bj) { const int col = u.pn * 256 + bj * 128 + wc * 32 + 8 * fq;
            const f32x4 b0 = *(const f32x4*)(bias + col), b1 = *(const f32x4*)(bias + col + 4);
#pragma unroll
            for (int ai = 0; ai < 2; ++ai)
#pragma unroll
                for (int m = 0; m < 4; ++m) { const int row = u.pm * 256 + ai * 128 + wr * 64 + m * 16 + fr;
                    bf16_t* yp = Y + (size_t)row * DM + col; f32x4 z0, z1; unpack8(*(const u32x4*)(yp + 512), z0, z1);
                    f32x4 v0 = acc[ai][bj][m][0] + b0, v1 = acc[ai][bj][m][1] + b1;
#pragma unroll
                    for (int i = 0; i < 4; ++i) { v0[i] = z0[i] * sigmoidf_(v0[i]); v1[i] = z1[i] * sigmoidf_(v1[i]); }
                    *(u32x4*)yp = pack8(v0, v1); } }
        return false;
    }
};
struct EpiMerged {
    const bf16_t *G1, *G2; bf16_t* O;
    __device__ __forceinline__ bool operator()(f32x4 (&acc)[2][2][4][2], const eng::Unit& u, int wr, int wc, int fr, int fq) const {
        asm volatile("" : "+v"(fr), "+v"(fq));
        const int row0 = u.pm * 256 + wr * 64 + fr, col0 = u.pn * 256 + wc * 32 + 8 * fq;
        const bf16_t* G = u.aux ? G2 : G1;
#pragma unroll
        for (int ai = 0; ai < 2; ++ai)
#pragma unroll
            for (int m = 0; m < 4; ++m) { const size_t off = (size_t)(row0 + ai * 128 + m * 16) * DM + col0;
#pragma unroll
                for (int bj = 0; bj < 2; ++bj) { f32x4 c0, c1; unpack8(*(const u32x4*)(G + off + bj * 128), c0, c1);
                    f32x4 v0 = acc[ai][bj][m][0] * c0, v1 = acc[ai][bj][m][1] * c1;
                    if (u.aux) { f32x4 p0, p1; unpack8(*(const u32x4*)(O + off + bj * 128), p0, p1); v0 = v0 + p0; v1 = v1 + p1; }
                    *(u32x4*)(O + off + bj * 128) = pack8(v0, v1); } }
        return false;
    }
};

struct SchedMerged {
    const char *Ys, *Ya, *Ws, *Wa; int G, c; eng::TileSched T;
    __device__ __forceinline__ bool next(int i, eng::Unit& u) const {
        if (!T.next(i >> 1, u)) return false;
        const int seg = i & 1; u.aux = seg;
        u.A = (seg ? Ya : Ys) + (size_t)u.pm * 256 * (DM * 2); u.B = (seg ? Wa : Ws) + (size_t)u.pn * 256 * (DM * 2); u.nt = seg ? 16 : 8; return true;
    }
};
struct SchedSsdE {
    const char *AG, *BTE; int G, c;
    __device__ __forceinline__ bool next(int i, eng::Unit& u) const {
        const int L = i * G + c; if (L >= NGRP * 3) return false;
        const int g = L / 3, pmc = L % 3; u.aux = g; u.pm = pmc; u.pn = 0; u.nt = 8;
        u.A = AG + ((size_t)g * CRS + 256 * pmc) * (AGLD * 2) + 256; u.B = BTE + (size_t)g * 128 * 1024; return true;
    }
};
struct SchedSsdY {
    const char *AG, *BTY; int G, c;
    __device__ __forceinline__ bool next(int i, eng::Unit& u) const {
        const int L = i * G + c; if (L >= NGRP * 6) return false;
        const int g = L / 6, r = L % 6, pmc = r >> 1, pn = r & 1; u.aux = g; u.pm = pmc; u.pn = pn; u.nt = pn ? 10 : 6;
        u.A = AG + ((size_t)g * CRS + 256 * pmc) * (AGLD * 2); u.B = BTY + ((size_t)g * 512 + 256 * pn) * (AGLD * 2); return true;
    }
};

template <class RowMap>
__device__ __forceinline__ void transpose_item(const float* W, int K, int N, bf16_t* WT, int ldw, LAS float* scr, int item, int lane, const RowMap& rowmap) {
    const int nblk = N / 32, kb = item / nblk, nb = item % nblk, k0 = 64 * kb, n0 = 32 * nb;
#pragma unroll 8
    for (int i = 0; i < 32; ++i) { const int kk = 2 * i + (lane >> 5); scr[kk * 33 + (lane & 31)] = W[(size_t)(k0 + kk) * N + n0 + (lane & 31)]; }
    asm volatile("s_waitcnt lgkmcnt(0)" ::: "memory");
    const int c = lane & 7;
#pragma unroll
    for (int j = 0; j < 4; ++j) { const int n = (lane >> 3) + 8 * j; const LAS float* s = scr + (8 * c) * 33 + n;
        u32x4 o; o.x = f2bf(s[0 * 33]) | (f2bf(s[1 * 33]) << 16); o.y = f2bf(s[2 * 33]) | (f2bf(s[3 * 33]) << 16); o.z = f2bf(s[4 * 33]) | (f2bf(s[5 * 33]) << 16); o.w = f2bf(s[6 * 33]) | (f2bf(s[7 * 33]) << 16);
        *(u32x4*)(WT + (size_t)rowmap(n0 + n) * ldw + k0 + 8 * c) = o; }
    asm volatile("s_waitcnt lgkmcnt(0)" ::: "memory");
}
struct MapId { __device__ __forceinline__ int operator()(int n) const { return n; } };
struct MapWin { __device__ __forceinline__ int operator()(int n) const { if (n < 512 || n >= 1792) return n; const int base = n & ~63; return base + qk_phys(n & 63); } };

__device__ __forceinline__ void prep_weights(const Ctx& C, int l, int gw, int ngw) {
    const ParamsPtr PP = C.p; unsigned char* ws = C.ws;
    LAS float* scr = (LAS float*)(C.lds + C.wave * 16384);
    const float* Win = PP->in[I_WIN] + (size_t)l * DM * DIN; const float* Wglu = PP->in[I_WGLU] + (size_t)l * DSSM * DSSM;
    const float* Wos = PP->in[I_WOS] + (size_t)l * DSSM * DM; const float* Woa = PP->in[I_WOA] + (size_t)l * DATT * DM;
    const float* Wout = PP->in[I_WOUT] + (size_t)l * DM * DM; const float* Wup = PP->in[I_WUP] + (size_t)l * DM * DFF; const float* Wdn = PP->in[I_WDN] + (size_t)l * DFF * DM;
    constexpr int I_1 = (DM / 64) * (DIN / 32), I_2 = (DSSM / 64) * (DSSM / 32), I_3 = (DSSM / 64) * (DM / 32), I_4 = (DATT / 64) * (DM / 32), I_5 = (DM / 64) * (DM / 32), I_6 = (DM / 64) * (DFF / 32), I_7 = (DFF / 64) * (DM / 32);
    constexpr int NIT = I_1 + I_2 + I_3 + I_4 + I_5 + I_6 + I_7;
    for (int it = gw; it < NIT; it += ngw) {
        int r = it;
        if (r < I_1) { transpose_item(Win, DM, DIN, (bf16_t*)(ws + WS_WIN), DM, scr, r, C.lane, MapWin()); continue; } r -= I_1;
        if (r < I_2) { transpose_item(Wglu, DSSM, DSSM, (bf16_t*)(ws + WS_WGLU), DSSM, scr, r, C.lane, MapId()); continue; } r -= I_2;
        if (r < I_3) { transpose_item(Wos, DSSM, DM, (bf16_t*)(ws + WS_WOS), DM, scr, r, C.lane, MapId()); continue; } r -= I_3;
        if (r < I_4) { transpose_item(Woa, DATT, DM, (bf16_t*)(ws + WS_WOA), DM, scr, r, C.lane, MapId()); continue; } r -= I_4;
        if (r < I_5) { transpose_item(Wout, DM, DM, (bf16_t*)(ws + WS_WOUT), DM, scr, r, C.lane, MapId()); continue; } r -= I_5;
        if (r < I_6) { transpose_item(Wup, DM, DFF, (bf16_t*)(ws + WS_WUP), DM, scr, r, C.lane, MapId()); continue; } r -= I_6;
        transpose_item(Wdn, DFF, DM, (bf16_t*)(ws + WS_WDN), DFF, scr, r, C.lane, MapId());
    }
}

__device__ __forceinline__ void prep_ssd_group(const Ctx& C, int l, int g) {
    const ParamsPtr PP = C.p; unsigned char* ws = C.ws; const int tid = C.tid;
    LAS f32x2* pw = (LAS f32x2*)(C.lds);
    LAS f32x2* bbar = (LAS f32x2*)(C.lds + 33 * 64 * 8);
    LAS f32x2* cc = bbar + 64 * 16;
    LAS float* ktab = (LAS float*)(cc + 16 * 64);
    const float dt = expf(PP->in[I_LOGDT][l * NGRP + g]);
    const float* are = PP->in[I_ARE] + (size_t)(l * NGRP + g) * NST; const float* aim = PP->in[I_AIM] + (size_t)(l * NGRP + g) * NST;
    const float* bre = PP->in[I_BRE] + (size_t)(l * NGRP + g) * NST * GCH; const float* bim = PP->in[I_BIM] + (size_t)(l * NGRP + g) * NST * GCH;
    const float* cre = PP->in[I_CRE] + (size_t)(l * NGRP + g) * GCH * NST; const float* cim = PP->in[I_CIM] + (size_t)(l * NGRP + g) * GCH * NST;
    const float* dsk = PP->in[I_SSMD] + (size_t)(l * NGRP + g) * GCH;
    __syncthreads();
    for (int e = tid; e < 33 * 64; e += NTHREADS) { const int k = e >> 6, n = e & 63; const float mag = expf((float)k * are[n] * dt), ang = (float)k * aim[n] * dt; float s, c; sincosf(ang, &s, &c); pw[e] = (f32x2){mag * c, mag * s}; }
    for (int e = tid; e < 16 * 64; e += NTHREADS) cc[e] = (f32x2){cre[e], cim[e]};
    __syncthreads();
    for (int e = tid; e < 64 * 16; e += NTHREADS) { const int n = e >> 4; const f32x2 ab = pw[64 + n]; const float ar = are[n], ai = aim[n], nr = ab.x - 1.f, ni = ab.y, den = 1.f / (ar * ar + ai * ai);
        const float qr = (nr * ar + ni * ai) * den, qi = (ni * ar - nr * ai) * den;
        const float br = bre[e], bi = bim[e]; bbar[e] = (f32x2){qr * br - qi * bi, qr * bi + qi * br}; }
    if (tid < 64) ((f32x2*)(ws + WS_A32))[g * 64 + tid] = pw[32 * 64 + tid];
    __syncthreads();
    for (int e = tid; e < 32 * 256; e += NTHREADS) { const int tau = e >> 8, c = (e >> 4) & 15, c2 = e & 15; float s = 0.f;
        for (int n = 0; n < 64; ++n) { const f32x2 cv = cc[c * 64 + n], pv = pw[tau * 64 + n], bv = bbar[n * 16 + c2];
            const float xr = cv.x * pv.x - cv.y * pv.y, xi = cv.x * pv.y + cv.y * pv.x; s += xr * bv.x - xi * bv.y; }
        if (tau == 0 && c == c2) s += dsk[c];
        ktab[e] = s; }
    __syncthreads();
    bf16_t* bty = (bf16_t*)(ws + WS_BTY) + (size_t)g * 512 * AGLD;
    for (int e = tid; e < 512 * (AGLD / 8); e += NTHREADS) { const int r = e / (AGLD / 8), c8 = (e % (AGLD / 8)) * 8, t = r >> 4, c = r & 15; float v[8];
#pragma unroll
        for (int i = 0; i < 8; ++i) { const int col = c8 + i;
            if (col < 128) { const int n = col & 63; const f32x2 cv = cc[c * 64 + n], pv = pw[(t + 1) * 64 + n]; v[i] = (col < 64) ? (cv.x * pv.x - cv.y * pv.y) : -(cv.x * pv.y + cv.y * pv.x); }
            else { const int j = (col - 128) >> 4, c2 = (col - 128) & 15; v[i] = (j <= t) ? ktab[(t - j) * 256 + c * 16 + c2] : 0.f; } }
        u32x4 o; o.x = f2bf(v[0]) | (f2bf(v[1]) << 16); o.y = f2bf(v[2]) | (f2bf(v[3]) << 16); o.z = f2bf(v[4]) | (f2bf(v[5]) << 16); o.w = f2bf(v[6]) | (f2bf(v[7]) << 16);
        *(u32x4*)(bty + (size_t)r * AGLD + c8) = o; }
    bf16_t* bte = (bf16_t*)(ws + WS_BTE) + (size_t)g * 128 * 512;
    for (int e = tid; e < 128 * 64; e += NTHREADS) { const int r = e >> 6, c8 = (e & 63) * 8, n = r & 63, j = c8 >> 4, c0 = c8 & 15; const f32x2 pv = pw[(31 - j) * 64 + n]; float v[8];
#pragma unroll
        for (int i = 0; i < 8; ++i) { const f32x2 bv = bbar[n * 16 + c0 + i]; v[i] = (r < 64) ? (pv.x * bv.x - pv.y * bv.y) : (pv.x * bv.y + pv.y * bv.x); }
        u32x4 o; o.x = f2bf(v[0]) | (f2bf(v[1]) << 16); o.y = f2bf(v[2]) | (f2bf(v[3]) << 16); o.z = f2bf(v[4]) | (f2bf(v[5]) << 16); o.w = f2bf(v[6]) | (f2bf(v[7]) << 16);
        *(u32x4*)(bte + (size_t)r * 512 + c8) = o; }
    __syncthreads();
}

__device__ __forceinline__ void prep_layer(const Ctx& C, int l) {
    const int NG = C.G;
    if (NG >= 64) {
        if (C.vcu < NGRP) prep_ssd_group(C, l, C.vcu);
        else prep_weights(C, l, (C.vcu - NGRP) * NWAVES + C.wave, (NG - NGRP) * NWAVES);
    } else {
        for (int g = C.vcu; g < NGRP; g += NG) prep_ssd_group(C, l, g);
        prep_weights(C, l, C.vcu * NWAVES + C.wave, NG * NWAVES);
    }
}

__device__ __forceinline__ void norm_row(const float* xin, const bf16_t* mix, const float* gpost, float* xout, bf16_t* h, const float* gpre, int lane) {
    f32x4 v[4];
#pragma unroll
    for (int j = 0; j < 4; ++j) v[j] = *(const f32x4*)(xin + 256 * j + 4 * lane);
    if (mix) {
        f32x4 mv[4]; float s = 0.f;
#pragma unroll
        for (int j = 0; j < 4; ++j) { const u32x2 w = *(const u32x2*)(mix + 256 * j + 4 * lane);
            mv[j][0] = __uint_as_float(w.x << 16); mv[j][1] = __uint_as_float(w.x & 0xffff0000u); mv[j][2] = __uint_as_float(w.y << 16); mv[j][3] = __uint_as_float(w.y & 0xffff0000u);
            s += (mv[j][0] * mv[j][0] + mv[j][1] * mv[j][1]) + (mv[j][2] * mv[j][2] + mv[j][3] * mv[j][3]); }
        const float r1 = 1.f / sqrtf(wave_sum(s) * (1.f / DM) + RMS_EPS);
#pragma unroll
        for (int j = 0; j < 4; ++j) { const f32x4 gp = *(const f32x4*)(gpost + 256 * j + 4 * lane); v[j] = v[j] + mv[j] * r1 * gp; }
    }
    if (xout) {
#pragma unroll
        for (int j = 0; j < 4; ++j) *(f32x4*)(xout + 256 * j + 4 * lane) = v[j]; }
    if (h) {
        float s2 = 0.f;
#pragma unroll
        for (int j = 0; j < 4; ++j) s2 += (v[j][0] * v[j][0] + v[j][1] * v[j][1]) + (v[j][2] * v[j][2] + v[j][3] * v[j][3]);
        const float r2 = 1.f / sqrtf(wave_sum(s2) * (1.f / DM) + RMS_EPS);
#pragma unroll
        for (int j = 0; j < 4; ++j) { const f32x4 gp = *(const f32x4*)(gpre + 256 * j + 4 * lane); const f32x4 o = v[j] * r2 * gp;
            u32x2 w; w.x = cvt_pk_bf16(o[0], o[1]); w.y = cvt_pk_bf16(o[2], o[3]); *(u32x2*)(h + 256 * j + 4 * lane) = w; }
    }
}

__device__ __forceinline__ void norm_phase(const Ctx& C, const float* xsrc_main, const bf16_t* mix, const float* gpost, const float* gpre, bool write_h) {
    const ParamsPtr PP = C.p; const int gw = C.vcu * NWAVES + C.wave, ngw = C.G * NWAVES;
    bf16_t* H = (bf16_t*)(C.ws + WS_H); float* xm = (float*)(C.ws + WS_XMETA);
    for (int r = gw; r < MMAIN + NMETA; r += ngw) {
        const bool meta = r >= MMAIN;
        const float* xin = meta ? (xm + (size_t)(r - MMAIN) * DM) : (xsrc_main + (size_t)r * DM);
        float* xout = meta ? (xm + (size_t)(r - MMAIN) * DM) : (PP->out + (size_t)r * DM);
        norm_row(xin, mix ? mix + (size_t)r * DM : nullptr, gpost, (mix || (!meta && xsrc_main != PP->out)) ? xout : nullptr, write_h ? H + (size_t)r * DM : nullptr, gpre, C.lane);
    }
}

__device__ __forceinline__ int crow(int r, int hi) { return (r & 3) + 8 * (r >> 2) + 4 * hi; }
__device__ __forceinline__ void attn_phase(const Ctx& C, int l) {
    const ParamsPtr PP = C.p; unsigned char* ws = C.ws;
    bf16_t* Q = (bf16_t*)(ws + WS_Q); const bf16_t* KH = (const bf16_t*)(ws + WS_KH); const bf16_t* VT = (const bf16_t*)(ws + WS_VT);
    const bf16_t* KHM = (const bf16_t*)(ws + WS_KHM); const bf16_t* VTM = (const bf16_t*)(ws + WS_VTM);
    const float* sinks = PP->in[I_SINKS] + l * NQH;
    const int lane = C.lane, r32 = lane & 31, hi = lane >> 5;
    const int gw = C.vcu * NWAVES + C.wave, ngw = C.G * NWAVES;
    constexpr int NTASK = NB * NQH * (SEQ / 32) + NQH;
    const float NEG = -INFINITY;
    for (int task = gw; task < NTASK; task += ngw) {
        const bool mtask = task >= NB * NQH * (SEQ / 32);
        int b, kvh, qh, t0; size_t qrow0;
        if (!mtask) { const int gq = task & 3, blk = (task >> 2) & 255, bk = task >> 10; b = bk >> 2; kvh = bk & 3; qh = kvh * 4 + gq; t0 = blk * 32; qrow0 = (size_t)b * SEQ + t0; }
        else { qh = task - NB * NQH * (SEQ / 32); kvh = qh >> 2; b = 0; t0 = 0; qrow0 = META0; }
        bf16_t* Qp = Q + (qrow0 + r32) * DM + qh * HD;
        bf16x8 qf[4];
#pragma unroll
        for (int s = 0; s < 4; ++s) qf[s] = *(const bf16x8*)(Qp + 16 * s + 8 * hi);
        const bf16_t* Kb = KH + (size_t)(b * NKVH + kvh) * SEQ * HD; const bf16_t* Vb = VT + (size_t)(b * NKVH + kvh) * HD * SEQ;
        f32x16 S[6];
        { const bf16_t* kp = KHM + (kvh * NMETA + (r32 & 15)) * HD + 8 * hi; f32x16 a = {};
#pragma unroll
          for (int s = 0; s < 4; ++s) a = __builtin_amdgcn_mfma_f32_32x32x16_bf16(*(const bf16x8*)(kp + 16 * s), qf[s], a, 0, 0, 0);
#pragma unroll
          for (int r = 0; r < 16; ++r) { const int key = crow(r, hi); bool ok = key < 16; if (mtask) ok = ok && (key <= r32); if (!ok) a[r] = NEG; }
          S[0] = a; }
#pragma unroll
        for (int j = 0; j < 5; ++j) {
            const int tb = t0 - 128 + 32 * j; f32x16 a = {};
            if (!mtask && tb >= 0) {
                const bf16_t* kp = Kb + (size_t)(tb + r32) * HD + 8 * hi;
#pragma unroll
                for (int s = 0; s < 4; ++s) a = __builtin_amdgcn_mfma_f32_32x32x16_bf16(*(const bf16x8*)(kp + 16 * s), qf[s], a, 0, 0, 0);
                if (j == 0) {
#pragma unroll
                    for (int r = 0; r < 16; ++r) if (crow(r, hi) <= r32) a[r] = NEG; }
                if (j == 4) {
#pragma unroll
                    for (int r = 0; r < 16; ++r) if (crow(r, hi) > r32) a[r] = NEG; }
            } else {
#pragma unroll
                for (int r = 0; r < 16; ++r) a[r] = NEG; }
            S[1 + j] = a; }
        const float sk = sinks[qh] * LOG2E;
        float m = sk;
#pragma unroll
        for (int j = 0; j < 6; ++j)
#pragma unroll
            for (int r = 0; r < 16; ++r) m = fmaxf(m, S[j][r]);
        m = fmaxf(m, __shfl_xor(m, 32));
        float lsum = 0.f;
#pragma unroll
        for (int j = 0; j < 6; ++j)
#pragma unroll
            for (int r = 0; r < 16; ++r) { const float e = __builtin_amdgcn_exp2f(S[j][r] - m); S[j][r] = e; lsum += e; }
        lsum += __shfl_xor(lsum, 32);
        lsum += __builtin_amdgcn_exp2f(sk - m);
        const float rl = 1.f / lsum;
        f32x16 O0 = {}, O1 = {};
#pragma unroll
        for (int j = 0; j < 6; ++j) {
            const int tb = t0 - 128 + 32 * (j - 1);
            if (j > 0 && (mtask || tb < 0)) continue;
#pragma unroll
            for (int s = 0; s < 2; ++s) {
                u32x4 pw; pw.x = cvt_pk_bf16(S[j][8 * s + 0] * rl, S[j][8 * s + 1] * rl); pw.y = cvt_pk_bf16(S[j][8 * s + 2] * rl, S[j][8 * s + 3] * rl);
                pw.z = cvt_pk_bf16(S[j][8 * s + 4] * rl, S[j][8 * s + 5] * rl); pw.w = cvt_pk_bf16(S[j][8 * s + 6] * rl, S[j][8 * s + 7] * rl);
                const bf16x8 pa = __builtin_bit_cast(bf16x8, pw);
#pragma unroll
                for (int dt = 0; dt < 2; ++dt) {
                    const int d = 32 * dt + r32; u32x2 lo, hi2;
                    if (j == 0) { if (s == 0) { const bf16_t* vp = VTM + (kvh * HD + d) * NMETA + 4 * hi; lo = *(const u32x2*)vp; hi2 = *(const u32x2*)(vp + 8); } else { lo = (u32x2){0u, 0u}; hi2 = lo; } }
                    else { const bf16_t* vp = Vb + (size_t)d * SEQ + tb + 16 * s + 4 * hi; lo = *(const u32x2*)vp; hi2 = *(const u32x2*)(vp + 8); }
                    u32x4 vw; vw.x = lo.x; vw.y = lo.y; vw.z = hi2.x; vw.w = hi2.y; const bf16x8 vb = __builtin_bit_cast(bf16x8, vw);
                    if (dt == 0) O0 = __builtin_amdgcn_mfma_f32_32x32x16_bf16(pa, vb, O0, 0, 0, 0); else O1 = __builtin_amdgcn_mfma_f32_32x32x16_bf16(pa, vb, O1, 0, 0, 0);
                } } }
        bf16_t* Op = Q + qrow0 * DM + qh * HD + r32;
#pragma unroll
        for (int r = 0; r < 16; ++r) { const int q = crow(r, hi); Op[(size_t)q * DM] = (bf16_t)f2bf(O0[r]); Op[(size_t)q * DM + 32] = (bf16_t)f2bf(O1[r]); }
    }
}

__device__ __forceinline__ void carry_phase(const Ctx& C) {
    unsigned char* ws = C.ws; const float* E = (const float*)(ws + WS_E); bf16_t* AG = (bf16_t*)(ws + WS_AG); const f32x2* A32 = (const f32x2*)(ws + WS_A32);
    const int gw = C.vcu * NWAVES + C.wave, ngw = C.G * NWAVES, n = C.lane;
    for (int w = gw; w < NB * NGRP; w += ngw) {
        const int b = w / NGRP, g = w % NGRP;
        const f32x2 a = A32[g * 64 + n];
        const float* em = E + ((size_t)g * CRS + NCHUNK) * 128;
        float sr = em[n], si = em[64 + n];
        if (b == 0) { bf16_t* mp = AG + ((size_t)g * CRS + NCHUNK) * AGLD; mp[n] = 0; mp[64 + n] = 0; }
        for (int c0 = 0; c0 < NCHUNK / NB; c0 += 8) {
            float er[8], ei[8];
#pragma unroll
            for (int i = 0; i < 8; ++i) { const float* ep = E + ((size_t)g * CRS + b * (NCHUNK / NB) + c0 + i) * 128; er[i] = ep[n]; ei[i] = ep[64 + n]; }
#pragma unroll
            for (int i = 0; i < 8; ++i) { bf16_t* ap = AG + ((size_t)g * CRS + b * (NCHUNK / NB) + c0 + i) * AGLD; ap[n] = (bf16_t)f2bf(sr); ap[64 + n] = (bf16_t)f2bf(si);
                const float nr = a.x * sr - a.y * si + er[i], ni = a.x * si + a.y * sr + ei[i]; sr = nr; si = ni; }
        }
    }
}

#define NPHASE 23
__device__ __forceinline__ void run_phase(Ctx& C, const int ph) {
    const ParamsPtr PP = C.p; unsigned char* ws = C.ws;
    const int gw = C.vcu * NWAVES + C.wave, ngw = C.G * NWAVES;
    bf16_t* H = (bf16_t*)(ws + WS_H);
    if (ph == 0) {
        prep_layer(C, 0);
        float* cosT = (float*)(ws + WS_COS); float* sinT = (float*)(ws + WS_SIN);
        for (int e = C.bx * NTHREADS + C.tid; e < (SEQ + NMETA) * 32; e += C.G * NTHREADS) { const int pos = e >> 5, j = e & 31;
            const float inv = exp2f(-(float)j * (13.287712379549449f / 32.f));
            float sn, cs; sincosf((float)pos * inv, &sn, &cs); cosT[e] = cs; sinT[e] = sn; }
        { float* xm = (float*)(ws + WS_XMETA); const float* mt = PP->in[I_META];
          for (int e = C.bx * NTHREADS + C.tid; e < NMETA * DM; e += C.G * NTHREADS) xm[e] = mt[e]; }
        { bf16_t* AG = (bf16_t*)(ws + WS_AG);
          for (int e = C.bx * NTHREADS + C.tid; e < NGRP * 256; e += C.G * NTHREADS) { const int g = e >> 8, c = e & 255; AG[((size_t)g * CRS + NCHUNK) * AGLD + 128 + c] = 0; } }
        for (int r = gw; r < MMAIN + NMETA; r += ngw) {
            const bool meta = r >= MMAIN; const float* xin = meta ? (PP->in[I_META] + (size_t)(r - MMAIN) * DM) : (PP->in[I_X] + (size_t)r * DM);
            norm_row(xin, nullptr, nullptr, nullptr, H + (size_t)r * DM, PP->in[I_NMIXPRE], C.lane); }
        return;
    }
    const int l = (ph - 1) / 11, k = (ph - 1) % 11;
    switch (k) {
    case 0: {
        eng::TileSched S; S.init(H, ws + WS_WIN, DM * 2, DM * 2, DM, MR, DIN, C.G, C.bx);
        EpiWin E{(bf16_t*)(ws + WS_AG), (bf16_t*)(ws + WS_Q), (bf16_t*)(ws + WS_KH), (bf16_t*)(ws + WS_VT), (bf16_t*)(ws + WS_KHM), (bf16_t*)(ws + WS_VTM), (bf16_t*)(ws + WS_G1), (bf16_t*)(ws + WS_G2),
                 (const float*)(ws + WS_COS), (const float*)(ws + WS_SIN)};
        eng::gemm_phase(C.lds, C.tid, DM * 2, DM * 2, S, E);
    } break;
    case 1: {
        SchedSsdE S{(const char*)(ws + WS_AG), (const char*)(ws + WS_BTE), C.G, C.bx};
        EpiSsdE E{(float*)(ws + WS_E)};
        eng::gemm_phase(C.lds, C.tid, AGLD * 2, 512 * 2, S, E);
        attn_phase(C, l);
    } break;
    case 2: carry_phase(C); break;
    case 3: {
        SchedSsdY S{(const char*)(ws + WS_AG), (const char*)(ws + WS_BTY), C.G, C.bx};
        EpiSsdY E{H};
        eng::gemm_phase(C.lds, C.tid, AGLD * 2, AGLD * 2, S, E);
    } break;
    case 4: {
        eng::TileSched S; S.init(H + 512, ws + WS_WGLU, DM * 2, DSSM * 2, DSSM, MR, DSSM, C.G, C.bx);
        EpiGlu E{H, PP->in[I_BGLU] + l * DSSM};
        eng::gemm_phase(C.lds, C.tid, DM * 2, DSSM * 2, S, E);
    } break;
    case 5: {
        SchedMerged S; S.Ys = (const char*)H; S.Ya = (const char*)(ws + WS_Q); S.Ws = (const char*)(ws + WS_WOS); S.Wa = (const char*)(ws + WS_WOA); S.G = C.G; S.c = C.bx;
        S.T.init(H, ws + WS_WOS, DM * 2, DM * 2, DM, MR, DM, C.G, C.bx);
        EpiMerged E{(const bf16_t*)(ws + WS_G1), (const bf16_t*)(ws + WS_G2), (bf16_t*)(ws + WS_MERGED)};
        eng::gemm_phase(C.lds, C.tid, DM * 2, DM * 2, S, E);
    } break;
    case 6: {
        eng::TileSched S; S.init(ws + WS_MERGED, ws + WS_WOUT, DM * 2, DM * 2, DM, MR, DM, C.G, C.bx);
        EpiStore<0> E{(bf16_t*)(ws + WS_MIX), DM};
        eng::gemm_phase(C.lds, C.tid, DM * 2, DM * 2, S, E);
    } break;
    case 7:
        norm_phase(C, l == 0 ? PP->in[I_X] : PP->out, (const bf16_t*)(ws + WS_MIX), PP->in[I_NMIXPOST] + l * DM, PP->in[I_NMLPPRE] + l * DM, true);
        break;
    case 8: {
        eng::TileSched S; S.init(H, ws + WS_WUP, DM * 2, DM * 2, DM, MR, DFF, C.G, C.bx);
        EpiStore<1> E{(bf16_t*)(ws + WS_FF), DFF};
        eng::gemm_phase(C.lds, C.tid, DM * 2, DM * 2, S, E);
    } break;
    case 9: {
        eng::TileSched S; S.init(ws + WS_FF, ws + WS_WDN, DFF * 2, DFF * 2, DFF, MR, DM, C.G, C.bx);
        EpiStore<0> E{H, DM};
        eng::gemm_phase(C.lds, C.tid, DFF * 2, DFF * 2, S, E);
    } break;
    default: {
        norm_phase(C, PP->out, H, PP->in[I_NMLPPOST] + l * DM, PP->in[I_NMIXPRE] + (l + 1 < DEPTH ? l + 1 : l) * DM, l + 1 < DEPTH);
        if (l + 1 < DEPTH) {
            prep_layer(C, l + 1);
            bf16_t* AG = (bf16_t*)(ws + WS_AG);
            for (int e = C.bx * NTHREADS + C.tid; e < NGRP * 256; e += C.G * NTHREADS) { const int g = e >> 8, c = e & 255; AG[((size_t)g * CRS + NCHUNK) * AGLD + 128 + c] = 0; }
        }
    } break;
    }
}

__global__ void __launch_bounds__(NTHREADS, 2) fwd_kernel(Params P_) {
    extern __shared__ __attribute__((aligned(16))) unsigned char lds_raw[];
    Ctx C; C.lds = (LAS unsigned char*)lds_raw; C.tid = threadIdx.x; C.lane = C.tid & 63; C.wave = __builtin_amdgcn_readfirstlane(C.tid >> 6);
    C.G = gridDim.x; C.bx = blockIdx.x; C.vcu = C.bx;
    ParamsPtr pp0 = (ParamsPtr)__builtin_amdgcn_kernarg_segment_ptr();
    C.p = pp0; C.ws = pp0->ws;
    volatile LAS unsigned* MISC = (volatile LAS unsigned*)(C.lds + LDSCTL_OFF + 320);
    for (int u = C.tid; u < (LDS_BYTES - LDSCTL_OFF) / 4; u += NTHREADS) ((LAS unsigned*)(C.lds + LDSCTL_OFF))[u] = 0u;
    __syncthreads();
    const int lo = pp0->ph_lo, hi = pp0->ph_hi;
    XcdBarrier bar; bar.bar = (unsigned*)(C.ws + WS_CTL) + CW_BAR; bar.x = 0; bar.st = nullptr;
    if (hi - lo > 1) bar = xcd_barrier_post((unsigned*)(C.ws + WS_CTL) + CW_BAR, MISC + 8);
    for (int ph = lo; ph < hi; ++ph) {
        ParamsPtr pp = (ParamsPtr)__builtin_amdgcn_kernarg_segment_ptr();
        asm volatile("" : "+s"(pp));
        C.p = pp; C.ws = pp->ws;
        { int t_ = threadIdx.x, g_ = gridDim.x, b_ = blockIdx.x; asm volatile("" : "+v"(t_), "+s"(g_), "+s"(b_));
          C.tid = t_; C.lane = t_ & 63; C.wave = __builtin_amdgcn_readfirstlane(t_ >> 6); C.G = g_; C.bx = b_; C.vcu = (g_ % 8 == 0) ? (b_ % 8) * (g_ / 8) + b_ / 8 : b_; }
        run_phase(C, ph);
        if (ph + 1 < hi) xcd_barrier(bar);
    }
}

#ifdef PROBE_STOP
__global__ void probe_dump_bf16(const bf16_t* src, int ld, float* out) {
    for (size_t e = (size_t)blockIdx.x * blockDim.x + threadIdx.x; e < (size_t)MMAIN * DM; e += (size_t)gridDim.x * blockDim.x) { const size_t r = e >> 10, c = e & 1023; out[e] = bf2f(src[r * ld + c]); }
}
#endif
extern "C" void kernel_launch(void* const* d_in, const int* in_sizes, int n_in, void* d_out, int out_size, void* d_ws, size_t ws_size, hipStream_t stream) {
    static int grid = 0;
    if (grid == 0) {
        if (n_in != 23 || out_size != MMAIN * DM || ws_size < WS_END) { fprintf(stderr, "kernel_launch: unexpected shapes (n_in %d out %d ws %zu)\n", n_in, out_size, ws_size); grid = -1; return; }
        int dev = 0, cus = 0, per_cu = 0;
        if (hipGetDevice(&dev) != hipSuccess || hipDeviceGetAttribute(&cus, hipDeviceAttributeMultiprocessorCount, dev) != hipSuccess) { grid = -1; return; }
        if (hipFuncSetAttribute((const void*)fwd_kernel, hipFuncAttributeMaxDynamicSharedMemorySize, LDS_BYTES) != hipSuccess) { fprintf(stderr, "kernel_launch: hipFuncSetAttribute failed\n"); grid = -1; return; }
        if (hipOccupancyMaxActiveBlocksPerMultiprocessor(&per_cu, (const void*)fwd_kernel, NTHREADS, LDS_BYTES) != hipSuccess || per_cu < 1) fprintf(stderr, "kernel_launch: occupancy query says %d\n", per_cu);
        (void)hipGetLastError();
        grid = cus;
    }
    if (grid < 0) return;
    (void)hipMemsetAsync((char*)d_ws + WS_CTL, 0, CTL_ZERO_BYTES, stream);
    Params p{};
    for (int i = 0; i < 23; ++i) p.in[i] = (const float*)d_in[i];
    p.out = (float*)d_out; p.ws = (unsigned char*)d_ws;
#ifndef N_LAUNCH_SPLIT
#define N_LAUNCH_SPLIT 0
#endif
#ifdef PROBE_STOP
    for (int ph = 0; ph <= PROBE_STOP; ++ph) { p.ph_lo = ph; p.ph_hi = ph + 1; hipLaunchKernelGGL(fwd_kernel, dim3(grid), dim3(NTHREADS), LDS_BYTES, stream, p); }
    hipLaunchKernelGGL(probe_dump_bf16, dim3(2048), dim3(256), 0, stream, (const bf16_t*)((unsigned char*)d_ws + PROBE_BUF), PROBE_LD, (float*)d_out);
    return;
#endif
    if (N_LAUNCH_SPLIT) { for (int ph = 0; ph < NPHASE; ++ph) { p.ph_lo = ph; p.ph_hi = ph + 1; hipLaunchKernelGGL(fwd_kernel, dim3(grid), dim3(NTHREADS), LDS_BYTES, stream, p); } }
    else { p.ph_lo = 0; p.ph_hi = NPHASE; hipLaunchKernelGGL(fwd_kernel, dim3(grid), dim3(NTHREADS), LDS_BYTES, stream, p); }
}
```

```cpp
#include <hip/hip_runtime.h>
#include <cstdio>
#include <cstdint>

#define N_LAUNCH_SPLIT 0
#define PROBE_BUF WS_G2
#define PROBE_LD 1024
#ifndef CHECK_MODE
#define CHECK_MODE 0
#endif

#define GAS __attribute__((address_space(1)))
#define LAS __attribute__((address_space(3)))
typedef unsigned short bf16_t;
typedef short bf16x8 __attribute__((ext_vector_type(8)));
typedef short s16x4 __attribute__((ext_vector_type(4)));
typedef float f32x2 __attribute__((ext_vector_type(2)));
typedef float f32x4 __attribute__((ext_vector_type(4)));
typedef float f32x16 __attribute__((ext_vector_type(16)));
typedef unsigned u32x2 __attribute__((ext_vector_type(2)));
typedef unsigned u32x4 __attribute__((ext_vector_type(4)));

constexpr int NB = 2, SEQ = 8192, DM = 1024, NMETA = 16, DEPTH = 2;
constexpr int MMAIN = NB * SEQ;
constexpr int MR = 16640;
constexpr int META0 = MMAIN;
constexpr int DIN = 4096, DSSM = 512, DATT = 1024, DKV = 256, DFF = 4096;
constexpr int NQH = 16, NKVH = 4, HD = 64;
constexpr int NGRP = 32, NST = 64, GCH = 16;
constexpr int TCH = 32;
constexpr int NCHUNK = MMAIN / TCH;
constexpr int CRS = NCHUNK + 1;
constexpr int AGLD = 640;
constexpr float RMS_EPS = 1e-6f;
constexpr float QSCALE = 0.125f * 1.4426950408889634f;
constexpr float LOG2E = 1.4426950408889634f;

constexpr size_t MiB = 1u << 20;
constexpr size_t WS_CTL = 0, CTL_ZERO_BYTES = 1 * MiB;
constexpr size_t WS_COS = 1 * MiB, WS_SIN = 2 * MiB + 256 * 1024;
constexpr size_t WS_A32 = 3 * MiB + 512 * 1024;
constexpr size_t WS_XMETA = 3 * MiB + 768 * 1024;
constexpr size_t WS_KHM = 3 * MiB + 896 * 1024;
constexpr size_t WS_VTM = 3 * MiB + 928 * 1024;
constexpr size_t WS_CHK = 4 * MiB;
constexpr size_t WS_WIN = 6 * MiB;
constexpr size_t WS_WGLU = 14 * MiB;
constexpr size_t WS_WOS = 14 * MiB + 512 * 1024;
constexpr size_t WS_WOA = 16 * MiB + 512 * 1024;
constexpr size_t WS_WOUT = 18 * MiB + 512 * 1024;
constexpr size_t WS_WUP = 20 * MiB + 512 * 1024;
constexpr size_t WS_WDN = 28 * MiB + 512 * 1024;
constexpr size_t WS_H = 37 * MiB;
constexpr size_t WS_BTY = 70 * MiB;
constexpr size_t WS_BTE = 90 * MiB;
constexpr size_t WS_AG = 94 * MiB + 512 * 1024;
constexpr size_t WS_E = 115 * MiB;
constexpr size_t WS_KH = 123 * MiB + 512 * 1024;
constexpr size_t WS_VT = 131 * MiB + 512 * 1024;
constexpr size_t WS_Q = 139 * MiB + 512 * 1024;
constexpr size_t WS_G1 = 172 * MiB;
constexpr size_t WS_G2 = 204 * MiB + 512 * 1024;
constexpr size_t WS_END = 237 * MiB;
constexpr size_t WS_MERGED = WS_AG;
constexpr size_t WS_MIX = WS_G1;
constexpr size_t WS_FF = WS_BTY;
static_assert(WS_FF + (size_t)MR * DFF * 2 <= WS_END, "ff overlay");
static_assert(WS_AG + ((size_t)NGRP * CRS + 255) * AGLD * 2 <= WS_E, "AG");
static_assert(WS_E + (size_t)NGRP * CRS * 128 * 4 <= WS_KH, "E");
static_assert(WS_MERGED + (size_t)MR * DM * 2 <= WS_VT, "merged overlay");
static_assert(WS_H + (size_t)MR * DM * 2 <= WS_BTY, "H");
static_assert(WS_BTE + (size_t)(NGRP * 128 + 128) * 512 * 2 <= WS_AG, "BTE");

constexpr int CW_BAR = 4096;
constexpr int CW_CHK = 1024;

#define RLX_AGENT __ATOMIC_RELAXED, __HIP_MEMORY_SCOPE_AGENT
__device__ __forceinline__ float bf2f(bf16_t v) { return __uint_as_float((unsigned)v << 16); }
__device__ __forceinline__ unsigned f2bf(float f) { unsigned u = __float_as_uint(f); return (u + 0x7fffu + ((u >> 16) & 1u)) >> 16; }
typedef __bf16 bf16x2_t __attribute__((ext_vector_type(2)));
__device__ __forceinline__ unsigned cvt_pk_bf16(float lo, float hi) { const f32x2 v = {lo, hi}; const bf16x2_t b = __builtin_convertvector(v, bf16x2_t); return __builtin_bit_cast(unsigned, b); }
__device__ __forceinline__ float sigmoidf_(float x) { return __builtin_amdgcn_rcpf(1.f + __builtin_amdgcn_exp2f(-x * LOG2E)); }
__device__ __forceinline__ float gelu_tanh(float y) { const float k = 0.7978845608028654f * (y + 0.044715f * y * y * y); return y * __builtin_amdgcn_rcpf(1.f + __builtin_amdgcn_exp2f(-2.f * LOG2E * k)); }
__device__ __forceinline__ float wave_sum(float v) {
#pragma unroll
    for (int o = 1; o < 64; o <<= 1) v += __shfl_xor(v, o);
    return v;
}
__host__ __device__ __forceinline__ int qk_phys(int d) { return 32 * ((d >> 4) & 1) + 8 * ((d >> 2) & 3) + 4 * (d >> 5) + (d & 3); }

#define XB_TMO      128
#define XB_XCNT(j)  (256  + 64 * (j))
#define XB_XSUB(j)  (1280 + 64 * (j))
#define XB_XGEN(j)  (2304 + 64 * (j))
#define XB_TOP      3328
#define XB_TOPGEN   3392
#define XCD_BAR_WORDS 3456
#define XB_SPIN_CAP (1u << 20)
__device__ __forceinline__ unsigned xb_ld(unsigned* p)              { return __hip_atomic_load(p, __ATOMIC_RELAXED, __HIP_MEMORY_SCOPE_AGENT); }
__device__ __forceinline__ unsigned xb_add(unsigned* p, unsigned v) { return __hip_atomic_fetch_add(p, v, __ATOMIC_RELAXED, __HIP_MEMORY_SCOPE_AGENT); }
__device__ __forceinline__ unsigned xb_xcc_id() { return (unsigned)__builtin_amdgcn_s_getreg((3 << 11) | 20) & 0xFu; }
#define XB_SPIN(cond, bar) do { unsigned _sp = 0; while (cond) { __builtin_amdgcn_s_sleep(1); \
    if ((++_sp & 255u) == 0u) { if (xb_ld(&(bar)[XB_TMO])) break; if (_sp > XB_SPIN_CAP) { atomicAdd(&(bar)[XB_TMO], 1u); break; } } } } while (0)
struct XcdBarrier { unsigned* bar; unsigned x; volatile LAS unsigned* st; };
__device__ __forceinline__ XcdBarrier xcd_barrier_post(unsigned* bar, volatile LAS unsigned* st) {
    XcdBarrier b; b.bar = bar; b.x = xb_xcc_id(); b.st = st;
    if (threadIdx.x == 0) (void)xb_add(&bar[XB_XCNT(b.x)], 1u);
    return b;
}
__device__ __forceinline__ void xcd_barrier_complete(unsigned* bar, unsigned x, unsigned& nloc, unsigned& nx) {
    const unsigned G = gridDim.x * gridDim.y * gridDim.z;
    unsigned sum, cnt, mine, sp = 0u;
    for (;;) {
        sum = 0u; cnt = 0u; mine = 0u;
#pragma unroll
        for (unsigned j = 0; j < 16; ++j) { const unsigned c = xb_ld(&bar[XB_XCNT(j)]); sum += c; cnt += (c > 0u) ? 1u : 0u; mine = (j == x) ? c : mine; }
        if (sum == G) break;
        __builtin_amdgcn_s_sleep(1);
        if ((++sp & 255u) == 0u) { if (xb_ld(&bar[XB_TMO])) break; if (sp > XB_SPIN_CAP) { atomicAdd(&bar[XB_TMO], 1u); break; } }
    }
    nloc = mine > 0u ? mine : 1u; nx = cnt > 0u ? cnt : 1u;
}
__device__ __forceinline__ void xcd_barrier(const XcdBarrier& b) {
    asm volatile("s_waitcnt vmcnt(0)" ::: "memory");
    __syncthreads();
    if (threadIdx.x == 0) {
        unsigned* bar = b.bar;
        __builtin_amdgcn_s_waitcnt(0);
        unsigned nloc = b.st[0], nx = b.st[1];
        if (nloc == 0u) { xcd_barrier_complete(bar, b.x, nloc, nx); b.st[0] = nloc; b.st[1] = nx; }
        const unsigned old = xb_add(&bar[XB_XSUB(b.x)], 1u);
        const unsigned gen = old / nloc;
        if (old + 1u == (gen + 1u) * nloc) {
            __builtin_amdgcn_fence(__ATOMIC_RELEASE, "agent");
            asm volatile("s_waitcnt vmcnt(0)" ::: "memory");
            const unsigned og = xb_add(&bar[XB_TOP], 1u);
            const unsigned tg = og / nx;
            if (og + 1u == (tg + 1u) * nx) xb_add(&bar[XB_TOPGEN], 1u);
            else XB_SPIN(xb_ld(&bar[XB_TOPGEN]) == tg, bar);
            __builtin_amdgcn_fence(__ATOMIC_ACQUIRE, "agent");
            xb_add(&bar[XB_XGEN(b.x)], 1u);
            asm volatile("s_waitcnt vmcnt(0)" ::: "memory");
        } else {
            XB_SPIN(xb_ld(&bar[XB_XGEN(b.x)]) == gen, bar);
            __builtin_amdgcn_fence(__ATOMIC_ACQUIRE, "agent");
            asm volatile("s_waitcnt vmcnt(0)" ::: "memory");
        }
    }
    __syncthreads();
}

namespace eng {
constexpr int BM = 256, BK = 64, HALF = 128, HTB = HALF * BK * 2, STAGE_BYTES = 8 * HTB, NXCD = 8, WGM = 8;
__host__ __device__ __forceinline__ int lds_byte(int r, int c) { const int st = (r >> 4) * 2 + (c >> 5), rr = r & 15, cc = c & 31, ob = rr * 64 + cc * 2; return st * 1024 + (ob ^ (((ob >> 9) & 1) << 5)); }
__host__ __device__ __forceinline__ void stage_rc(int b, int& R, int& C) { const int st = b / 1024, sb = b % 1024, swz = sb ^ (((sb >> 9) & 1) << 5); R = (st >> 1) * 16 + swz / 64; C = (st & 1) * 32 + (swz % 64) / 2; }
__host__ __device__ __forceinline__ int perm32(int rho) { const int n = rho >> 4, i = rho & 15; return 8 * (i >> 2) + 4 * n + (i & 3); }

struct Unit { const char* A; const char* B; int nt, pm, pn, aux; };

template <class Epi, class Sched>
__device__ __forceinline__ void gemm_phase(LAS unsigned char* lds, const int tid, const int lda, const int ldb, const Sched& S, const Epi& E) {
    const int wid = __builtin_amdgcn_readfirstlane(tid >> 6), lane = tid & 63, wr = wid >> 2, wc = wid & 3, fr = lane & 15, fq = lane >> 4;
    unsigned voffA[2], voffB[2];
#pragma unroll
    for (int i = 0; i < 2; ++i) { int R, C; stage_rc(tid * 16 + i * 8192, R, C); const int Rb = (R & ~31) + perm32(R & 31);
        voffA[i] = (unsigned)(R * lda + C * 2); voffB[i] = (unsigned)(Rb * ldb + C * 2); }
    const size_t kstep = (size_t)(BK * 2);
    const size_t hstepA = (size_t)HALF * lda, hstepB = (size_t)HALF * ldb;
    const unsigned ldsw = (unsigned)wid * 1024u;
    const int aoff = lds_byte(wr * 64 + fr, fq * 8), boff = lds_byte(wc * 32 + fr, fq * 8);
#define PG8_SA(b, h) (((b) * 2 + (h)) * HTB)
#define PG8_SB(b, h) ((4 + (b) * 2 + (h)) * HTB)
#define PG8_STAGE(bufoff, gbase, voff) do { _Pragma("unroll") for (int _i = 0; _i < 2; ++_i) \
        __builtin_amdgcn_global_load_lds((const unsigned*)((const char*)(gbase) + (voff)[_i]), (LAS unsigned*)(lds + (bufoff) + ldsw + _i * 8192), 16, 0, 0); } while (0)
#define PG8_LDA(dst, b, h) do { _Pragma("unroll") for (int m = 0; m < 4; ++m) _Pragma("unroll") for (int k = 0; k < 2; ++k) dst[m][k] = *(const LAS bf16x8*)(lds + PG8_SA(b, h) + aoff + m * 2048 + k * 1024); } while (0)
#define PG8_LDB(dst, b, h) do { _Pragma("unroll") for (int n = 0; n < 2; ++n) _Pragma("unroll") for (int k = 0; k < 2; ++k) dst[n][k] = *(const LAS bf16x8*)(lds + PG8_SB(b, h) + boff + n * 2048 + k * 1024); } while (0)
#define PG8_MMA(ai, bj, At, Bt) do { __builtin_amdgcn_s_setprio(1); _Pragma("unroll") for (int m = 0; m < 4; ++m) _Pragma("unroll") for (int n = 0; n < 2; ++n) _Pragma("unroll") for (int k = 0; k < 2; ++k) \
        acc[ai][bj][m][n] = __builtin_amdgcn_mfma_f32_16x16x32_bf16(Bt[n][k], At[m][k], acc[ai][bj][m][n], 0, 0, 0); __builtin_amdgcn_s_setprio(0); } while (0)
#define PG8_WAIT_V(n) asm volatile("s_waitcnt vmcnt(" #n ")" ::: "memory")
#define PG8_WAIT_L(n) asm volatile("s_waitcnt lgkmcnt(" #n ")" ::: "memory")
#define PG8_BAR __builtin_amdgcn_s_barrier()
#define PG8_SCHED __builtin_amdgcn_sched_barrier(0)
    Unit cur, nxt; int ui = 0;
    if (!S.next(0, cur)) return;
    f32x4 acc[2][2][4][2];
#pragma unroll
    for (int a = 0; a < 2; ++a)
#pragma unroll
        for (int b = 0; b < 2; ++b)
#pragma unroll
            for (int m = 0; m < 4; ++m)
#pragma unroll
                for (int n = 0; n < 2; ++n) acc[a][b][m][n] = (f32x4){0.f, 0.f, 0.f, 0.f};
    bf16x8 At[4][2], B0[2][2], B1[2][2];
    const char* cA = cur.A; const char* cB = cur.B;
    PG8_STAGE(PG8_SB(0, 0), cB, voffB); PG8_STAGE(PG8_SB(0, 1), cB + hstepB, voffB); PG8_STAGE(PG8_SA(0, 0), cA, voffA); PG8_STAGE(PG8_SA(0, 1), cA + hstepA, voffA);
    if (wr == 1) PG8_BAR;
    PG8_WAIT_V(2); PG8_BAR;
    PG8_STAGE(PG8_SB(1, 0), cB + kstep, voffB); PG8_STAGE(PG8_SA(1, 0), cA + kstep, voffA); PG8_STAGE(PG8_SB(1, 1), cB + hstepB + kstep, voffB);
    PG8_WAIT_V(6); PG8_BAR;
    for (;;) {
        const bool has_next = S.next(ui + 1, nxt);
        const char* nA = has_next ? nxt.A : cA; const char* nB = has_next ? nxt.B : cB;
        const int nt = cur.nt;
        for (int t = 0; t < nt; t += 2) {
            const bool last = (t == nt - 2);
            const char* a1 = cA + (size_t)(t + 1) * kstep;
            const char* a2 = last ? nA : cA + (size_t)(t + 2) * kstep; const char* b2 = last ? nB : cB + (size_t)(t + 2) * kstep;
            const char* a3 = a2 + kstep; const char* b3 = b2 + kstep;
            PG8_LDB(B0, 0, 0); PG8_LDB(B1, 0, 1); PG8_SCHED; PG8_LDA(At, 0, 0); PG8_STAGE(PG8_SA(1, 1), a1 + hstepA, voffA);
            PG8_WAIT_V(8); PG8_WAIT_L(0); PG8_BAR; PG8_MMA(0, 0, At, B0); PG8_MMA(0, 1, At, B1); PG8_BAR; PG8_SCHED;
            PG8_LDA(At, 0, 1); PG8_STAGE(PG8_SB(0, 0), b2, voffB); PG8_STAGE(PG8_SB(0, 1), b2 + hstepB, voffB); PG8_STAGE(PG8_SA(0, 0), a2, voffA);
            PG8_WAIT_V(8); PG8_WAIT_L(0); PG8_BAR; PG8_MMA(1, 0, At, B0); PG8_MMA(1, 1, At, B1); PG8_BAR; PG8_SCHED;
            PG8_LDB(B0, 1, 0); PG8_LDB(B1, 1, 1); PG8_SCHED; PG8_LDA(At, 1, 0); PG8_STAGE(PG8_SA(0, 1), a2 + hstepA, voffA);
            PG8_WAIT_V(8); PG8_WAIT_L(0); PG8_BAR; PG8_MMA(0, 0, At, B0); PG8_MMA(0, 1, At, B1); PG8_BAR; PG8_SCHED;
            PG8_LDA(At, 1, 1); PG8_STAGE(PG8_SB(1, 0), b3, voffB); PG8_STAGE(PG8_SB(1, 1), b3 + hstepB, voffB); PG8_STAGE(PG8_SA(1, 0), a3, voffA);
            PG8_WAIT_V(8); PG8_WAIT_L(0); PG8_BAR; PG8_MMA(1, 0, At, B0); PG8_MMA(1, 1, At, B1); PG8_BAR; PG8_SCHED;
        }
        if (wr == 0) PG8_BAR;
        const bool keep = E(acc, cur, wr, wc, fr, fq);
        if (!has_next) break;
        if (!keep) {
#pragma unroll
        for (int a = 0; a < 2; ++a)
#pragma unroll
            for (int b = 0; b < 2; ++b)
#pragma unroll
                for (int m = 0; m < 4; ++m)
#pragma unroll
                    for (int n = 0; n < 2; ++n) acc[a][b][m][n] = (f32x4){0.f, 0.f, 0.f, 0.f};
        }
        cur = nxt; cA = nA; cB = nB; ++ui;
        if (wr == 1) PG8_BAR;
    }
    PG8_WAIT_V(0);
    PG8_BAR;
#undef PG8_SA
#undef PG8_SB
#undef PG8_STAGE
#undef PG8_LDA
#undef PG8_LDB
#undef PG8_MMA
#undef PG8_WAIT_V
#undef PG8_WAIT_L
#undef PG8_BAR
#undef PG8_SCHED
}

struct TileSched {
    const char* A; const char* B; int lda, ldb, nt, nM, nN, nwg, G, c;
    __device__ __forceinline__ void init(const void* A_, const void* B_, int lda_, int ldb_, int K, int M, int N, int G_, int c_) {
        A = (const char*)A_; B = (const char*)B_; lda = lda_; ldb = ldb_; nt = K / BK; nM = M / BM; nN = N / BM; nwg = nM * nN; G = G_; c = c_; }
    __device__ __forceinline__ bool next(int i, Unit& u) const {
        const long L = (long)i * G + c; if (L >= nwg) return false;
        int wgid = (int)L; { const int q = nwg / NXCD, r = nwg % NXCD, xcd = wgid % NXCD, off = wgid / NXCD; wgid = (xcd < r ? xcd * (q + 1) : r * (q + 1) + (xcd - r) * q) + off; }
        const int nig = WGM * nN, gid = wgid / nig, fm = gid * WGM, gsz = (nM - fm) < WGM ? (nM - fm) : WGM;
        u.pm = fm + ((wgid % nig) % gsz); u.pn = (wgid % nig) / gsz; u.nt = nt; u.aux = 0;
        u.A = A + (size_t)u.pm * BM * lda; u.B = B + (size_t)u.pn * BM * ldb; return true;
    }
};
}

struct Params { const float* in[23]; float* out; unsigned char* ws; int ph_lo, ph_hi; };
enum { I_X = 0, I_META, I_NMIXPRE, I_NMIXPOST, I_NMLPPRE, I_NMLPPOST, I_WIN, I_ARE, I_AIM, I_LOGDT, I_BRE, I_BIM, I_CRE, I_CIM, I_SSMD, I_WGLU, I_BGLU, I_SINKS, I_WOS, I_WOA, I_WOUT, I_WUP, I_WDN };

constexpr int NWAVES = 8, NTHREADS = 512;
constexpr int RING_BYTES = 131072, LDSCTL_OFF = RING_BYTES, LDS_BYTES = 147456;

#define CAS __attribute__((address_space(4)))
typedef const CAS Params* ParamsPtr;
struct Ctx {
    LAS unsigned char* lds; int tid, lane, wave, vcu, G, bx;
    ParamsPtr p; unsigned char* ws;
};

__device__ __forceinline__ u32x4 pack8(const f32x4 a, const f32x4 b) { u32x4 w; w.x = cvt_pk_bf16(a[0], a[1]); w.y = cvt_pk_bf16(a[2], a[3]); w.z = cvt_pk_bf16(b[0], b[1]); w.w = cvt_pk_bf16(b[2], b[3]); return w; }
__device__ __forceinline__ void unpack8(const u32x4 w, f32x4& a, f32x4& b) {
    a[0] = __uint_as_float(w.x << 16); a[1] = __uint_as_float(w.x & 0xffff0000u); a[2] = __uint_as_float(w.y << 16); a[3] = __uint_as_float(w.y & 0xffff0000u);
    b[0] = __uint_as_float(w.z << 16); b[1] = __uint_as_float(w.z & 0xffff0000u); b[2] = __uint_as_float(w.w << 16); b[3] = __uint_as_float(w.w & 0xffff0000u); }

template <class EF> struct EpiMain {
    EF f;
    __device__ __forceinline__ bool operator()(f32x4 (&acc)[2][2][4][2], const eng::Unit& u, int wr, int wc, int fr, int fq) const {
        asm volatile("" : "+v"(fr), "+v"(fq));
#pragma unroll
        for (int ai = 0; ai < 2; ++ai)
#pragma unroll
            for (int m = 0; m < 4; ++m) { const int row = u.pm * 256 + ai * 128 + wr * 64 + m * 16 + fr;
#pragma unroll
                for (int bj = 0; bj < 2; ++bj) f.elem(u.pn, u.aux, row, bj * 128 + wc * 32 + 8 * fq, acc[ai][bj][m][0], acc[ai][bj][m][1]); }
        return f.keep(u.aux);
    }
};

template <int ACT> struct EfStore {
    bf16_t* O; int ldc;
    __device__ __forceinline__ bool keep(int) const { return false; }
    __device__ __forceinline__ void elem(int pn, int, int row, int cl, f32x4& v0, f32x4& v1) const {
        f32x4 a = v0, b = v1;
        if (ACT == 1) {
#pragma unroll
            for (int i = 0; i < 4; ++i) { const float x = fmaxf(a[i], 0.f), y = fmaxf(b[i], 0.f); a[i] = x * x; b[i] = y * y; } }
        *(u32x4*)(O + (size_t)row * ldc + pn * 256 + cl) = pack8(a, b);
    }
};

struct EfWin {
    bf16_t *AG, *Q, *KH, *VT, *KHM, *VTM, *G1, *G2; const float *cosT, *sinT;
    __device__ __forceinline__ bool keep(int) const { return false; }
    __device__ __forceinline__ void elem(int pn, int, int row, int cl, f32x4& v0, f32x4& v1) const {
        const bool is_main = row < MMAIN; const int b = row >> 13, t = row & (SEQ - 1), mi = row - META0;
        const int pos = is_main ? (t + NMETA) : mi;
        if (pn < 2) {
            const int j = pn * 256 + cl, g = j >> 4, c0 = j & 15;
            const int cr = is_main ? (row >> 5) : NCHUNK, tt = is_main ? (row & 31) : (16 + mi);
            *(u32x4*)(AG + ((size_t)g * CRS + cr) * AGLD + 128 + tt * 16 + c0) = pack8(v0, v1);
        } else if (pn < 7) {
            const int jf = 16 * ((cl >> 5) & 1) + 4 * ((cl >> 3) & 3);
            const f32x4 cs = *(const f32x4*)(cosT + pos * 32 + jf), sn = *(const f32x4*)(sinT + pos * 32 + jf);
            f32x4 o0 = v0 * cs - v1 * sn, o1 = v1 * cs + v0 * sn;
            if (pn < 6) { o0 = o0 * QSCALE; o1 = o1 * QSCALE; *(u32x4*)(Q + (size_t)row * DM + (pn - 2) * 256 + cl) = pack8(o0, o1); }
            else { const int kvh = cl >> 6, p = cl & 63;
                if (is_main) *(u32x4*)(KH + ((size_t)(b * NKVH + kvh) * SEQ + t) * HD + p) = pack8(o0, o1);
                else *(u32x4*)(KHM + (kvh * NMETA + mi) * HD + p) = pack8(o0, o1); }
        } else if (pn == 7) {
            const int kvh = cl >> 6, d0 = cl & 63; const u32x4 w = pack8(v0, v1);
            const unsigned ww[4] = {w.x, w.y, w.z, w.w};
            if (is_main) { bf16_t* vp = VT + ((size_t)(b * NKVH + kvh) * HD + d0) * SEQ + t;
#pragma unroll
                for (int i = 0; i < 8; ++i) vp[(size_t)i * SEQ] = (bf16_t)((ww[i >> 1] >> ((i & 1) * 16)) & 0xffffu); }
            else { bf16_t* vp = VTM + (kvh * HD + d0) * NMETA + mi;
#pragma unroll
                for (int i = 0; i < 8; ++i) vp[i * NMETA] = (bf16_t)((ww[i >> 1] >> ((i & 1) * 16)) & 0xffffu); }
        } else {
            f32x4 a = v0, c = v1;
#pragma unroll
            for (int i = 0; i < 4; ++i) { a[i] = sigmoidf_(a[i]); c[i] = sigmoidf_(c[i]); }
            bf16_t* gp = (pn < 12) ? (G1 + (size_t)row * DM + (pn - 8) * 256 + cl) : (G2 + (size_t)row * DM + (pn - 12) * 256 + cl);
            *(u32x4*)gp = pack8(a, c);
        }
    }
};

struct EfSsdE {
    float* E;
    __device__ __forceinline__ bool keep(int) const { return false; }
    __device__ __forceinline__ void elem(int, int g, int cr, int cl, f32x4& v0, f32x4& v1) const {
        if (cl < 128) { float* ep = E + ((size_t)g * CRS + cr) * 128 + cl; *(f32x4*)ep = v0; *(f32x4*)(ep + 4) = v1; }
    }
};
struct EfSsdY {
    bf16_t* Y;
    __device__ __forceinline__ bool keep(int) const { return false; }
    __device__ __forceinline__ void elem(int pn, int g, int cr, int cl, f32x4& v0, f32x4& v1) const {
        const int t = 16 * pn + (cl >> 4), c0 = cl & 15;
        int row = -1;
        if (cr < NCHUNK) row = cr * TCH + t; else if (cr == NCHUNK && t >= 16) row = META0 + t - 16;
        if (row >= 0) { f32x4 a = v0, c = v1;
#pragma unroll
            for (int i = 0; i < 4; ++i) { a[i] = gelu_tanh(a[i]); c[i] = gelu_tanh(c[i]); }
            *(u32x4*)(Y + (size_t)row * DM + 512 + g * 16 + c0) = pack8(a, c); }
    }
};
struct EfGlu {
    bf16_t* Y; const float* bias;
    __device__ __forceinline__ bool keep(int) const { return false; }
    __device__ __forceinline__ void elem(int pn, int, int row, int cl, f32x4& v0, f32x4& v1) const {
        const int col = pn * 256 + cl; const f32x4 b0 = *(const f32x4*)(bias + col), b1 = *(const f32x4*)(bias + col + 4);
        bf16_t* yp = Y + (size_t)row * DM + col; f32x4 z0, z1; unpack8(*(const u32x4*)(yp + 512), z0, z1);
        f32x4 a = v0 + b0, c = v1 + b1;
#pragma unroll
        for (int i = 0; i < 4; ++i) { a[i] = z0[i] * sigmoidf_(a[i]); c[i] = z1[i] * sigmoidf_(c[i]); }
        *(u32x4*)yp = pack8(a, c);
    }
};
struct EfMerged {
    const bf16_t *G1, *G2; bf16_t* O;
    __device__ __forceinline__ bool keep(int aux) const { return aux == 0; }
    __device__ __forceinline__ void elem(int pn, int aux, int row, int cl, f32x4& v0, f32x4& v1) const {
        const size_t off = (size_t)row * DM + pn * 256 + cl; f32x4 c0, c1; unpack8(*(const u32x4*)(G2 + off), c0, c1);
        if (aux == 0) { f32x4 a0, a1; unpack8(*(const u32x4*)(G1 + off), a0, a1);
#pragma unroll
            for (int i = 0; i < 4; ++i) { v0[i] *= a0[i] * __builtin_amdgcn_rcpf(c0[i]); v1[i] *= a1[i] * __builtin_amdgcn_rcpf(c1[i]); }
        } else *(u32x4*)(O + off) = pack8(v0 * c0, v1 * c1);
    }
};

__device__ __forceinline__ void mini_dot(const Ctx& C, const char* A, int lda, int nrows, const char* Bc, int ldb, int nsteps, f32x4& v0, f32x4& v1) {
    const int lane = C.lane, fr = lane & 15, fq = lane >> 4;
    const char* ap = A + (size_t)(fr < nrows ? fr : nrows - 1) * lda + fq * 16;
    const char* bp0 = Bc + (size_t)(8 * (fr >> 2) + (fr & 3)) * ldb + fq * 16; const char* bp1 = bp0 + (size_t)4 * ldb;
    f32x4 a0 = {0.f, 0.f, 0.f, 0.f}, a1 = {0.f, 0.f, 0.f, 0.f};
#pragma unroll 4
    for (int s = C.wave; s < nsteps; s += NWAVES) { const bf16x8 af = *(const bf16x8*)(ap + s * 64), b0 = *(const bf16x8*)(bp0 + s * 64), b1 = *(const bf16x8*)(bp1 + s * 64);
        a0 = __builtin_amdgcn_mfma_f32_16x16x32_bf16(b0, af, a0, 0, 0, 0); a1 = __builtin_amdgcn_mfma_f32_16x16x32_bf16(b1, af, a1, 0, 0, 0); }
    LAS f32x4* red = (LAS f32x4*)C.lds;
    red[(C.wave * 2 + 0) * 64 + lane] = a0; red[(C.wave * 2 + 1) * 64 + lane] = a1;
    __syncthreads();
    if (C.wave == 0) {
#pragma unroll
        for (int w = 1; w < NWAVES; ++w) { a0 = a0 + red[(w * 2 + 0) * 64 + lane]; a1 = a1 + red[(w * 2 + 1) * 64 + lane]; } }
    v0 = a0; v1 = a1;
    __syncthreads();
}
template <class EF>
__device__ __forceinline__ void mini_phase(const Ctx& C, const char* A, int lda, const char* B, int ldb, int N, int K, const EF& f) {
    for (int t = C.vcu; t < N / 32; t += C.G) {
        f32x4 v0, v1; mini_dot(C, A, lda, NMETA, B + (size_t)t * 32 * ldb, ldb, K / 32, v0, v1);
        if (C.wave == 0) { const int fr = C.lane & 15, fq = C.lane >> 4; f.elem(t >> 3, 0, META0 + fr, (t & 7) * 32 + 8 * fq, v0, v1); }
    }
}

struct SchedMerged {
    const char *Ys, *Ya, *Ws, *Wa; int G, c; eng::TileSched T;
    __device__ __forceinline__ bool next(int i, eng::Unit& u) const {
        if (!T.next(i >> 1, u)) return false;
        const int seg = i & 1; u.aux = seg;
        u.A = (seg ? Ya : Ys) + (size_t)u.pm * 256 * (DM * 2); u.B = (seg ? Wa : Ws) + (size_t)u.pn * 256 * (DM * 2); u.nt = seg ? 16 : 8; return true;
    }
};
struct SchedSsdE {
    const char *AG, *BTE; int G, c;
    __device__ __forceinline__ bool next(int i, eng::Unit& u) const {
        const int L = i * G + c; if (L >= NGRP * 2) return false;
        const int g = L >> 1, pmc = L & 1; u.aux = g; u.pm = pmc; u.pn = 0; u.nt = 8;
        u.A = AG + ((size_t)g * CRS + 256 * pmc) * (AGLD * 2) + 256; u.B = BTE + (size_t)g * 128 * 1024; return true;
    }
};
struct SchedSsdY {
    const char *AG, *BTY; int G, c;
    __device__ __forceinline__ bool next(int i, eng::Unit& u) const {
        const int L = i * G + c; if (L >= NGRP * 4) return false;
        const int g = L >> 2, r = L & 3, pmc = r >> 1, pn = r & 1; u.aux = g; u.pm = pmc; u.pn = pn; u.nt = pn ? 10 : 6;
        u.A = AG + ((size_t)g * CRS + 256 * pmc) * (AGLD * 2); u.B = BTY + ((size_t)g * 512 + 256 * pn) * (AGLD * 2); return true;
    }
};

template <class RowMap>
__device__ __forceinline__ void transpose_item(const float* W, int K, int N, bf16_t* WT, int ldw, int item, int lane, const RowMap& rowmap) {
    const int nblk = N / 64, kb = item / nblk, nb = item % nblk, k0 = 64 * kb + 16 * (lane >> 4), n0 = 64 * nb + 4 * (lane & 15);
    const float* wp = W + (size_t)k0 * N + n0;
    f32x4 v[16];
#pragma unroll
    for (int i = 0; i < 16; ++i) v[i] = __builtin_nontemporal_load((const f32x4*)(wp + (size_t)i * N));
#pragma unroll
    for (int j = 0; j < 4; ++j) { bf16_t* op = WT + (size_t)rowmap(n0 + j) * ldw + k0;
        u32x4 o0, o1;
        o0.x = cvt_pk_bf16(v[0][j], v[1][j]); o0.y = cvt_pk_bf16(v[2][j], v[3][j]); o0.z = cvt_pk_bf16(v[4][j], v[5][j]); o0.w = cvt_pk_bf16(v[6][j], v[7][j]);
        o1.x = cvt_pk_bf16(v[8][j], v[9][j]); o1.y = cvt_pk_bf16(v[10][j], v[11][j]); o1.z = cvt_pk_bf16(v[12][j], v[13][j]); o1.w = cvt_pk_bf16(v[14][j], v[15][j]);
        *(u32x4*)op = o0; *(u32x4*)(op + 8) = o1; }
}
struct MapId { __device__ __forceinline__ int operator()(int n) const { return n; } };
struct MapWin { __device__ __forceinline__ int operator()(int n) const { if (n < 512 || n >= 1792) return n; const int base = n & ~63; return base + qk_phys(n & 63); } };

__device__ __forceinline__ void prep_weights(const Ctx& C, int l, int gw, int ngw) {
    const ParamsPtr PP = C.p; unsigned char* ws = C.ws;
    const float* Win = PP->in[I_WIN] + (size_t)l * DM * DIN; const float* Wglu = PP->in[I_WGLU] + (size_t)l * DSSM * DSSM;
    const float* Wos = PP->in[I_WOS] + (size_t)l * DSSM * DM; const float* Woa = PP->in[I_WOA] + (size_t)l * DATT * DM;
    const float* Wout = PP->in[I_WOUT] + (size_t)l * DM * DM; const float* Wup = PP->in[I_WUP] + (size_t)l * DM * DFF; const float* Wdn = PP->in[I_WDN] + (size_t)l * DFF * DM;
    constexpr int I_1 = (DM / 64) * (DIN / 64), I_2 = (DSSM / 64) * (DSSM / 64), I_3 = (DSSM / 64) * (DM / 64), I_4 = (DATT / 64) * (DM / 64), I_5 = (DM / 64) * (DM / 64), I_6 = (DM / 64) * (DFF / 64), I_7 = (DFF / 64) * (DM / 64);
    constexpr int NIT = I_1 + I_2 + I_3 + I_4 + I_5 + I_6 + I_7;
    for (int it = gw; it < NIT; it += ngw) {
        int r = it;
        if (r < I_1) { transpose_item(Win, DM, DIN, (bf16_t*)(ws + WS_WIN), DM, r, C.lane, MapWin()); continue; } r -= I_1;
        if (r < I_2) { transpose_item(Wglu, DSSM, DSSM, (bf16_t*)(ws + WS_WGLU), DSSM, r, C.lane, MapId()); continue; } r -= I_2;
        if (r < I_3) { transpose_item(Wos, DSSM, DM, (bf16_t*)(ws + WS_WOS), DM, r, C.lane, MapId()); continue; } r -= I_3;
        if (r < I_4) { transpose_item(Woa, DATT, DM, (bf16_t*)(ws + WS_WOA), DM, r, C.lane, MapId()); continue; } r -= I_4;
        if (r < I_5) { transpose_item(Wout, DM, DM, (bf16_t*)(ws + WS_WOUT), DM, r, C.lane, MapId()); continue; } r -= I_5;
        if (r < I_6) { transpose_item(Wup, DM, DFF, (bf16_t*)(ws + WS_WUP), DM, r, C.lane, MapId()); continue; } r -= I_6;
        transpose_item(Wdn, DFF, DM, (bf16_t*)(ws + WS_WDN), DFF, r, C.lane, MapId());
    }
}

__device__ __forceinline__ void prep_ssd_group(const Ctx& C, int l, int g, int part) {
    const ParamsPtr PP = C.p; unsigned char* ws = C.ws; const int tid = C.tid;
    LAS f32x2* pw = (LAS f32x2*)(C.lds);
    LAS f32x2* bbar = (LAS f32x2*)(C.lds + 33 * 64 * 8);
    LAS f32x2* cc = bbar + 64 * 16;
    LAS float* ktab = (LAS float*)(cc + 16 * 64);
    const float dt = expf(PP->in[I_LOGDT][l * NGRP + g]);
    const float* are = PP->in[I_ARE] + (size_t)(l * NGRP + g) * NST; const float* aim = PP->in[I_AIM] + (size_t)(l * NGRP + g) * NST;
    const float* bre = PP->in[I_BRE] + (size_t)(l * NGRP + g) * NST * GCH; const float* bim = PP->in[I_BIM] + (size_t)(l * NGRP + g) * NST * GCH;
    const float* cre = PP->in[I_CRE] + (size_t)(l * NGRP + g) * GCH * NST; const float* cim = PP->in[I_CIM] + (size_t)(l * NGRP + g) * GCH * NST;
    const float* dsk = PP->in[I_SSMD] + (size_t)(l * NGRP + g) * GCH;
    __syncthreads();
    for (int e = tid; e < 33 * 64; e += NTHREADS) { const int k = e >> 6, n = e & 63; const float mag = expf((float)k * are[n] * dt), ang = (float)k * aim[n] * dt; float sn, cs; sincosf(ang, &sn, &cs); pw[e] = (f32x2){mag * cs, mag * sn}; }
    for (int e = tid; e < 16 * 64; e += NTHREADS) cc[e] = (f32x2){cre[e], cim[e]};
    __syncthreads();
    for (int e = tid; e < 64 * 16; e += NTHREADS) { const int n = e >> 4; const f32x2 ab = pw[64 + n]; const float ar = are[n], ai = aim[n], nr = ab.x - 1.f, ni = ab.y, den = 1.f / (ar * ar + ai * ai);
        const float qr = (nr * ar + ni * ai) * den, qi = (ni * ar - nr * ai) * den;
        const float br = bre[e], bi = bim[e]; bbar[e] = (f32x2){qr * br - qi * bi, qr * bi + qi * br}; }
    if (part == 0 && tid < 64) ((f32x2*)(ws + WS_A32))[g * 64 + tid] = pw[32 * 64 + tid];
    __syncthreads();
    { const int tau = tid >> 4, c = tid & 15; float acc[16];
#pragma unroll
      for (int i = 0; i < 16; ++i) acc[i] = 0.f;
      for (int n = 0; n < 64; ++n) { const f32x2 cv = cc[c * 64 + n], pv = pw[tau * 64 + n]; const float xr = cv.x * pv.x - cv.y * pv.y, xi = cv.x * pv.y + cv.y * pv.x;
#pragma unroll
          for (int i = 0; i < 16; ++i) { const f32x2 bv = bbar[n * 16 + i]; acc[i] += xr * bv.x - xi * bv.y; } }
      if (tau == 0) acc[c] += dsk[c];
#pragma unroll
      for (int i = 0; i < 16; ++i) ktab[tid * 16 + i] = acc[i]; }
    __syncthreads();
    bf16_t* bty = (bf16_t*)(ws + WS_BTY) + (size_t)g * 512 * AGLD;
    for (int e = tid; e < 128 * (AGLD / 8); e += NTHREADS) { const int r = part * 128 + e / (AGLD / 8), c8 = (e % (AGLD / 8)) * 8, t = r >> 4, c = r & 15; float v[8];
#pragma unroll
        for (int i = 0; i < 8; ++i) { const int col = c8 + i;
            if (col < 128) { const int n = col & 63; const f32x2 cv = cc[c * 64 + n], pv = pw[(t + 1) * 64 + n]; v[i] = (col < 64) ? (cv.x * pv.x - cv.y * pv.y) : -(cv.x * pv.y + cv.y * pv.x); }
            else { const int j = (col - 128) >> 4, c2 = (col - 128) & 15; v[i] = (j <= t) ? ktab[(t - j) * 256 + c * 16 + c2] : 0.f; } }
        u32x4 o; o.x = cvt_pk_bf16(v[0], v[1]); o.y = cvt_pk_bf16(v[2], v[3]); o.z = cvt_pk_bf16(v[4], v[5]); o.w = cvt_pk_bf16(v[6], v[7]);
        *(u32x4*)(bty + (size_t)r * AGLD + c8) = o; }
    bf16_t* bte = (bf16_t*)(ws + WS_BTE) + (size_t)g * 128 * 512;
    for (int e = tid; e < 32 * 64; e += NTHREADS) { const int r = part * 32 + (e >> 6), c8 = (e & 63) * 8, n = r & 63, j = c8 >> 4, c0 = c8 & 15; const f32x2 pv = pw[(31 - j) * 64 + n]; float v[8];
#pragma unroll
        for (int i = 0; i < 8; ++i) { const f32x2 bv = bbar[n * 16 + c0 + i]; v[i] = (r < 64) ? (pv.x * bv.x - pv.y * bv.y) : (pv.x * bv.y + pv.y * bv.x); }
        u32x4 o; o.x = cvt_pk_bf16(v[0], v[1]); o.y = cvt_pk_bf16(v[2], v[3]); o.z = cvt_pk_bf16(v[4], v[5]); o.w = cvt_pk_bf16(v[6], v[7]);
        *(u32x4*)(bte + (size_t)r * 512 + c8) = o; }
    __syncthreads();
}

__device__ __forceinline__ void prep_layer(const Ctx& C, int l) {
    for (int u = C.vcu; u < NGRP * 4; u += C.G) prep_ssd_group(C, l, u >> 2, u & 3);
    prep_weights(C, l, C.wave * C.G + (C.G - 1 - C.vcu), C.G * NWAVES);
}

__device__ __forceinline__ void norm_row(const float* xin, const bf16_t* mix, const float* gpost, float* xout, bf16_t* h, const float* gpre, int lane) {
    f32x4 v[4];
#pragma unroll
    for (int j = 0; j < 4; ++j) v[j] = *(const f32x4*)(xin + 256 * j + 4 * lane);
    if (mix) {
        f32x4 mv[4]; float s = 0.f;
#pragma unroll
        for (int j = 0; j < 4; ++j) { const u32x2 w = *(const u32x2*)(mix + 256 * j + 4 * lane);
            mv[j][0] = __uint_as_float(w.x << 16); mv[j][1] = __uint_as_float(w.x & 0xffff0000u); mv[j][2] = __uint_as_float(w.y << 16); mv[j][3] = __uint_as_float(w.y & 0xffff0000u);
            s += (mv[j][0] * mv[j][0] + mv[j][1] * mv[j][1]) + (mv[j][2] * mv[j][2] + mv[j][3] * mv[j][3]); }
        const float r1 = 1.f / sqrtf(wave_sum(s) * (1.f / DM) + RMS_EPS);
#pragma unroll
        for (int j = 0; j < 4; ++j) { const f32x4 gp = *(const f32x4*)(gpost + 256 * j + 4 * lane); v[j] = v[j] + mv[j] * r1 * gp; }
    }
    if (xout) {
#pragma unroll
        for (int j = 0; j < 4; ++j) *(f32x4*)(xout + 256 * j + 4 * lane) = v[j]; }
    if (h) {
        float s2 = 0.f;
#pragma unroll
        for (int j = 0; j < 4; ++j) s2 += (v[j][0] * v[j][0] + v[j][1] * v[j][1]) + (v[j][2] * v[j][2] + v[j][3] * v[j][3]);
        const float r2 = 1.f / sqrtf(wave_sum(s2) * (1.f / DM) + RMS_EPS);
#pragma unroll
        for (int j = 0; j < 4; ++j) { const f32x4 gp = *(const f32x4*)(gpre + 256 * j + 4 * lane); const f32x4 o = v[j] * r2 * gp;
            u32x2 w; w.x = cvt_pk_bf16(o[0], o[1]); w.y = cvt_pk_bf16(o[2], o[3]); *(u32x2*)(h + 256 * j + 4 * lane) = w; }
    }
}

__device__ __forceinline__ void norm_phase(const Ctx& C, const float* xsrc_main, const bf16_t* mix, const float* gpost, const float* gpre, bool write_h) {
    const ParamsPtr PP = C.p; const int gw = C.vcu * NWAVES + C.wave, ngw = C.G * NWAVES;
    bf16_t* H = (bf16_t*)(C.ws + WS_H); float* xm = (float*)(C.ws + WS_XMETA);
    for (int r = gw; r < MMAIN + NMETA; r += ngw) {
        const bool meta = r >= MMAIN;
        const float* xin = meta ? (xm + (size_t)(r - MMAIN) * DM) : (xsrc_main + (size_t)r * DM);
        float* xout = meta ? (xm + (size_t)(r - MMAIN) * DM) : (PP->out + (size_t)r * DM);
        norm_row(xin, mix ? mix + (size_t)r * DM : nullptr, gpost, (mix || (!meta && xsrc_main != PP->out)) ? xout : nullptr, write_h ? H + (size_t)r * DM : nullptr, gpre, C.lane);
    }
}

__device__ __forceinline__ int crow(int r, int hi) { return (r & 3) + 8 * (r >> 2) + 4 * hi; }
__device__ __forceinline__ void attn_phase(const Ctx& C, int l) {
    const ParamsPtr PP = C.p; unsigned char* ws = C.ws;
    bf16_t* Q = (bf16_t*)(ws + WS_Q); const bf16_t* KH = (const bf16_t*)(ws + WS_KH); const bf16_t* VT = (const bf16_t*)(ws + WS_VT);
    const bf16_t* KHM = (const bf16_t*)(ws + WS_KHM); const bf16_t* VTM = (const bf16_t*)(ws + WS_VTM);
    const float* sinks = PP->in[I_SINKS] + l * NQH;
    const int lane = C.lane, r32 = lane & 31, hi = lane >> 5;
    const int gw = C.vcu * NWAVES + C.wave, ngw = C.G * NWAVES;
    constexpr int NTASK = NB * NQH * (SEQ / 32) + NQH;
    const float NEG = -INFINITY;
    for (int task = gw; task < NTASK; task += ngw) {
        const bool mtask = task >= NB * NQH * (SEQ / 32);
        int b, kvh, qh, t0; size_t qrow0;
        if (!mtask) { const int gq = task & 3, blk = (task >> 2) & 255, bk = task >> 10; b = bk >> 2; kvh = bk & 3; qh = kvh * 4 + gq; t0 = blk * 32; qrow0 = (size_t)b * SEQ + t0; }
        else { qh = task - NB * NQH * (SEQ / 32); kvh = qh >> 2; b = 0; t0 = 0; qrow0 = META0; }
        bf16_t* Qp = Q + (qrow0 + r32) * DM + qh * HD;
        bf16x8 qf[4];
#pragma unroll
        for (int s = 0; s < 4; ++s) qf[s] = *(const bf16x8*)(Qp + 16 * s + 8 * hi);
        const bf16_t* Kb = KH + (size_t)(b * NKVH + kvh) * SEQ * HD; const bf16_t* Vb = VT + (size_t)(b * NKVH + kvh) * HD * SEQ;
        f32x16 S[6];
        { const bf16_t* kp = KHM + (kvh * NMETA + (r32 & 15)) * HD + 8 * hi; f32x16 a = {};
#pragma unroll
          for (int s = 0; s < 4; ++s) a = __builtin_amdgcn_mfma_f32_32x32x16_bf16(*(const bf16x8*)(kp + 16 * s), qf[s], a, 0, 0, 0);
#pragma unroll
          for (int r = 0; r < 16; ++r) { const int key = crow(r, hi); bool ok = key < 16; if (mtask) ok = ok && (key <= r32); if (!ok) a[r] = NEG; }
          S[0] = a; }
#pragma unroll
        for (int j = 0; j < 5; ++j) {
            const int tb = t0 - 128 + 32 * j; f32x16 a = {};
            if (!mtask && tb >= 0) {
                const bf16_t* kp = Kb + (size_t)(tb + r32) * HD + 8 * hi;
#pragma unroll
                for (int s = 0; s < 4; ++s) a = __builtin_amdgcn_mfma_f32_32x32x16_bf16(*(const bf16x8*)(kp + 16 * s), qf[s], a, 0, 0, 0);
                if (j == 0) {
#pragma unroll
                    for (int r = 0; r < 16; ++r) if (crow(r, hi) <= r32) a[r] = NEG; }
                if (j == 4) {
#pragma unroll
                    for (int r = 0; r < 16; ++r) if (crow(r, hi) > r32) a[r] = NEG; }
            } else {
#pragma unroll
                for (int r = 0; r < 16; ++r) a[r] = NEG; }
            S[1 + j] = a; }
        const float sk = sinks[qh] * LOG2E;
        float m = sk;
#pragma unroll
        for (int j = 0; j < 6; ++j)
#pragma unroll
            for (int r = 0; r < 16; ++r) m = fmaxf(m, S[j][r]);
        m = fmaxf(m, __shfl_xor(m, 32));
        float lsum = 0.f;
#pragma unroll
        for (int j = 0; j < 6; ++j)
#pragma unroll
            for (int r = 0; r < 16; ++r) { const float e = __builtin_amdgcn_exp2f(S[j][r] - m); S[j][r] = e; lsum += e; }
        lsum += __shfl_xor(lsum, 32);
        lsum += __builtin_amdgcn_exp2f(sk - m);
        const float rl = 1.f / lsum;
        f32x16 O0 = {}, O1 = {};
#pragma unroll
        for (int j = 0; j < 6; ++j) {
            const int tb = t0 - 128 + 32 * (j - 1);
            if (j > 0 && (mtask || tb < 0)) continue;
#pragma unroll
            for (int s = 0; s < 2; ++s) {
                u32x4 pw; pw.x = cvt_pk_bf16(S[j][8 * s + 0] * rl, S[j][8 * s + 1] * rl); pw.y = cvt_pk_bf16(S[j][8 * s + 2] * rl, S[j][8 * s + 3] * rl);
                pw.z = cvt_pk_bf16(S[j][8 * s + 4] * rl, S[j][8 * s + 5] * rl); pw.w = cvt_pk_bf16(S[j][8 * s + 6] * rl, S[j][8 * s + 7] * rl);
                const bf16x8 pa = __builtin_bit_cast(bf16x8, pw);
#pragma unroll
                for (int dt = 0; dt < 2; ++dt) {
                    const int d = 32 * dt + r32; u32x2 lo, hi2;
                    if (j == 0) { if (s == 0) { const bf16_t* vp = VTM + (kvh * HD + d) * NMETA + 4 * hi; lo = *(const u32x2*)vp; hi2 = *(const u32x2*)(vp + 8); } else { lo = (u32x2){0u, 0u}; hi2 = lo; } }
                    else { const bf16_t* vp = Vb + (size_t)d * SEQ + tb + 16 * s + 4 * hi; lo = *(const u32x2*)vp; hi2 = *(const u32x2*)(vp + 8); }
                    u32x4 vw; vw.x = lo.x; vw.y = lo.y; vw.z = hi2.x; vw.w = hi2.y; const bf16x8 vb = __builtin_bit_cast(bf16x8, vw);
                    if (dt == 0) O0 = __builtin_amdgcn_mfma_f32_32x32x16_bf16(pa, vb, O0, 0, 0, 0); else O1 = __builtin_amdgcn_mfma_f32_32x32x16_bf16(pa, vb, O1, 0, 0, 0);
                } } }
        bf16_t* Op = Q + qrow0 * DM + qh * HD + r32;
#pragma unroll
        for (int r = 0; r < 16; ++r) { const int q = crow(r, hi); Op[(size_t)q * DM] = (bf16_t)f2bf(O0[r]); Op[(size_t)q * DM + 32] = (bf16_t)f2bf(O1[r]); }
    }
}

__device__ __forceinline__ void carry_phase(const Ctx& C) {
    unsigned char* ws = C.ws; const float* E = (const float*)(ws + WS_E); bf16_t* AG = (bf16_t*)(ws + WS_AG); const f32x2* A32 = (const f32x2*)(ws + WS_A32);
    const int gw = C.vcu * NWAVES + C.wave, ngw = C.G * NWAVES, n = C.lane;
    for (int w = gw; w < NB * NGRP; w += ngw) {
        const int b = w / NGRP, g = w % NGRP;
        const f32x2 a = A32[g * 64 + n];
        const float* em = E + ((size_t)g * CRS + NCHUNK) * 128;
        float sr = em[n], si = em[64 + n];
        if (b == 0) { bf16_t* mp = AG + ((size_t)g * CRS + NCHUNK) * AGLD; mp[n] = 0; mp[64 + n] = 0; }
        for (int c0 = 0; c0 < NCHUNK / NB; c0 += 8) {
            float er[8], ei[8];
#pragma unroll
            for (int i = 0; i < 8; ++i) { const float* ep = E + ((size_t)g * CRS + b * (NCHUNK / NB) + c0 + i) * 128; er[i] = ep[n]; ei[i] = ep[64 + n]; }
#pragma unroll
            for (int i = 0; i < 8; ++i) { bf16_t* ap = AG + ((size_t)g * CRS + b * (NCHUNK / NB) + c0 + i) * AGLD; ap[n] = (bf16_t)f2bf(sr); ap[64 + n] = (bf16_t)f2bf(si);
                const float nr = a.x * sr - a.y * si + er[i], ni = a.x * si + a.y * sr + ei[i]; sr = nr; si = ni; }
        }
    }
}

#define NPHASE 23
__device__ __forceinline__ void run_phase(Ctx& C, const int ph) {
    const ParamsPtr PP = C.p; unsigned char* ws = C.ws;
    const int gw = C.vcu * NWAVES + C.wave, ngw = C.G * NWAVES;
    bf16_t* H = (bf16_t*)(ws + WS_H);
    if (ph == 0) {
        prep_layer(C, 0);
        float* cosT = (float*)(ws + WS_COS); float* sinT = (float*)(ws + WS_SIN);
        for (int e = C.bx * NTHREADS + C.tid; e < (SEQ + NMETA) * 32; e += C.G * NTHREADS) { const int pos = e >> 5, j = e & 31;
            const float inv = exp2f(-(float)j * (13.287712379549449f / 32.f));
            float sn, cs; sincosf((float)pos * inv, &sn, &cs); cosT[e] = cs; sinT[e] = sn; }
        { float* xm = (float*)(ws + WS_XMETA); const float* mt = PP->in[I_META];
          for (int e = C.bx * NTHREADS + C.tid; e < NMETA * DM; e += C.G * NTHREADS) xm[e] = mt[e]; }
        { bf16_t* AG = (bf16_t*)(ws + WS_AG);
          for (int e = C.bx * NTHREADS + C.tid; e < NGRP * 256; e += C.G * NTHREADS) { const int g = e >> 8, c = e & 255; AG[((size_t)g * CRS + NCHUNK) * AGLD + 128 + c] = 0; } }
        for (int r = gw; r < MMAIN + NMETA; r += ngw) {
            const bool meta = r >= MMAIN; const float* xin = meta ? (PP->in[I_META] + (size_t)(r - MMAIN) * DM) : (PP->in[I_X] + (size_t)r * DM);
            norm_row(xin, nullptr, nullptr, nullptr, H + (size_t)r * DM, PP->in[I_NMIXPRE], C.lane); }
        return;
    }
    const int l = (ph - 1) / 11, k = (ph - 1) % 11;
    switch (k) {
    case 0: {
        EfWin F{(bf16_t*)(ws + WS_AG), (bf16_t*)(ws + WS_Q), (bf16_t*)(ws + WS_KH), (bf16_t*)(ws + WS_VT), (bf16_t*)(ws + WS_KHM), (bf16_t*)(ws + WS_VTM), (bf16_t*)(ws + WS_G1), (bf16_t*)(ws + WS_G2),
                (const float*)(ws + WS_COS), (const float*)(ws + WS_SIN)};
        mini_phase(C, (const char*)(H + (size_t)META0 * DM), DM * 2, (const char*)(ws + WS_WIN), DM * 2, DIN, DM, F);
        eng::TileSched S; S.init(H, ws + WS_WIN, DM * 2, DM * 2, DM, MMAIN, DIN, C.G, C.bx);
        EpiMain<EfWin> E{F};
        eng::gemm_phase(C.lds, C.tid, DM * 2, DM * 2, S, E);
    } break;
    case 1: {
        EfSsdE F{(float*)(ws + WS_E)};
        for (int t = C.vcu; t < NGRP * 4; t += C.G) {
            const int g = t >> 2, q = t & 3; f32x4 v0, v1;
            mini_dot(C, (const char*)(ws + WS_AG) + ((size_t)g * CRS + NCHUNK) * (AGLD * 2) + 256, AGLD * 2, 1, (const char*)(ws + WS_BTE) + ((size_t)g * 128 + q * 32) * 1024, 1024, 16, v0, v1);
            if (C.wave == 0 && (C.lane & 15) == 0) F.elem(0, g, NCHUNK, q * 32 + 8 * (C.lane >> 4), v0, v1); }
        SchedSsdE S{(const char*)(ws + WS_AG), (const char*)(ws + WS_BTE), C.G, C.bx};
        EpiMain<EfSsdE> E{F};
        eng::gemm_phase(C.lds, C.tid, AGLD * 2, 512 * 2, S, E);
        attn_phase(C, l);
    } break;
    case 2: carry_phase(C); break;
    case 3: {
        EfSsdY F{H};
        for (int t = C.vcu; t < NGRP * 8; t += C.G) {
            const int g = t >> 3, q = t & 7; f32x4 v0, v1;
            mini_dot(C, (const char*)(ws + WS_AG) + ((size_t)g * CRS + NCHUNK) * (AGLD * 2), AGLD * 2, 1, (const char*)(ws + WS_BTY) + ((size_t)g * 512 + 256 + q * 32) * (AGLD * 2), AGLD * 2, 20, v0, v1);
            if (C.wave == 0 && (C.lane & 15) == 0) F.elem(1, g, NCHUNK, q * 32 + 8 * (C.lane >> 4), v0, v1); }
        SchedSsdY S{(const char*)(ws + WS_AG), (const char*)(ws + WS_BTY), C.G, C.bx};
        EpiMain<EfSsdY> E{F};
        eng::gemm_phase(C.lds, C.tid, AGLD * 2, AGLD * 2, S, E);
    } break;
    case 4: {
        EfGlu F{H, PP->in[I_BGLU] + l * DSSM};
        mini_phase(C, (const char*)(H + (size_t)META0 * DM + 512), DM * 2, (const char*)(ws + WS_WGLU), DSSM * 2, DSSM, DSSM, F);
        eng::TileSched S; S.init(H + 512, ws + WS_WGLU, DM * 2, DSSM * 2, DSSM, MMAIN, DSSM, C.G, C.bx);
        EpiMain<EfGlu> E{F};
        eng::gemm_phase(C.lds, C.tid, DM * 2, DSSM * 2, S, E);
    } break;
    case 5: {
        EfMerged F{(const bf16_t*)(ws + WS_G1), (const bf16_t*)(ws + WS_G2), (bf16_t*)(ws + WS_MERGED)};
        for (int t = C.vcu; t < DM / 32; t += C.G) {
            f32x4 s0, s1, a0, a1;
            mini_dot(C, (const char*)(H + (size_t)META0 * DM), DM * 2, NMETA, (const char*)(ws + WS_WOS) + (size_t)t * 32 * (DM * 2), DM * 2, DSSM / 32, s0, s1);
            mini_dot(C, (const char*)(ws + WS_Q) + (size_t)META0 * DM * 2, DM * 2, NMETA, (const char*)(ws + WS_WOA) + (size_t)t * 32 * (DM * 2), DM * 2, DATT / 32, a0, a1);
            if (C.wave == 0) { const int fr = C.lane & 15, fq = C.lane >> 4; const size_t off = (size_t)(META0 + fr) * DM + t * 32 + 8 * fq;
                f32x4 g10, g11, g20, g21; unpack8(*(const u32x4*)(F.G1 + off), g10, g11); unpack8(*(const u32x4*)(F.G2 + off), g20, g21);
                *(u32x4*)(F.O + off) = pack8(s0 * g10 + a0 * g20, s1 * g11 + a1 * g21); } }
        SchedMerged S; S.Ys = (const char*)H; S.Ya = (const char*)(ws + WS_Q); S.Ws = (const char*)(ws + WS_WOS); S.Wa = (const char*)(ws + WS_WOA); S.G = C.G; S.c = C.bx;
        S.T.init(H, ws + WS_WOS, DM * 2, DM * 2, DM, MMAIN, DM, C.G, C.bx);
        EpiMain<EfMerged> E{F};
        eng::gemm_phase(C.lds, C.tid, DM * 2, DM * 2, S, E);
    } break;
    case 6: {
        EfStore<0> F{(bf16_t*)(ws + WS_MIX), DM};
        mini_phase(C, (const char*)(ws + WS_MERGED) + (size_t)META0 * DM * 2, DM * 2, (const char*)(ws + WS_WOUT), DM * 2, DM, DM, F);
        eng::TileSched S; S.init(ws + WS_MERGED, ws + WS_WOUT, DM * 2, DM * 2, DM, MMAIN, DM, C.G, C.bx);
        EpiMain<EfStore<0>> E{F};
        eng::gemm_phase(C.lds, C.tid, DM * 2, DM * 2, S, E);
    } break;
    case 7:
        norm_phase(C, l == 0 ? PP->in[I_X] : PP->out, (const bf16_t*)(ws + WS_MIX), PP->in[I_NMIXPOST] + l * DM, PP->in[I_NMLPPRE] + l * DM, true);
        break;
    case 8: {
        EfStore<1> F{(bf16_t*)(ws + WS_FF), DFF};
        mini_phase(C, (const char*)(H + (size_t)META0 * DM), DM * 2, (const char*)(ws + WS_WUP), DM * 2, DFF, DM, F);
        eng::TileSched S; S.init(H, ws + WS_WUP, DM * 2, DM * 2, DM, MMAIN, DFF, C.G, C.bx);
        EpiMain<EfStore<1>> E{F};
        eng::gemm_phase(C.lds, C.tid, DM * 2, DM * 2, S, E);
    } break;
    case 9: {
        EfStore<0> F{H, DM};
        mini_phase(C, (const char*)(ws + WS_FF) + (size_t)META0 * DFF * 2, DFF * 2, (const char*)(ws + WS_WDN), DFF * 2, DM, DFF, F);
        eng::TileSched S; S.init(ws + WS_FF, ws + WS_WDN, DFF * 2, DFF * 2, DFF, MMAIN, DM, C.G, C.bx);
        EpiMain<EfStore<0>> E{F};
        eng::gemm_phase(C.lds, C.tid, DFF * 2, DFF * 2, S, E);
    } break;
    default: {
        norm_phase(C, PP->out, H, PP->in[I_NMLPPOST] + l * DM, PP->in[I_NMIXPRE] + (l + 1 < DEPTH ? l + 1 : l) * DM, l + 1 < DEPTH);
        if (l + 1 < DEPTH) {
            prep_layer(C, l + 1);
            bf16_t* AG = (bf16_t*)(ws + WS_AG);
            for (int e = C.bx * NTHREADS + C.tid; e < NGRP * 256; e += C.G * NTHREADS) { const int g = e >> 8, c = e & 255; AG[((size_t)g * CRS + NCHUNK) * AGLD + 128 + c] = 0; }
        }
    } break;
    }
}

__global__ void __launch_bounds__(NTHREADS, 2) fwd_kernel(Params P_) {
    extern __shared__ __attribute__((aligned(16))) unsigned char lds_raw[];
    Ctx C; C.lds = (LAS unsigned char*)lds_raw; C.tid = threadIdx.x; C.lane = C.tid & 63; C.wave = __builtin_amdgcn_readfirstlane(C.tid >> 6);
    C.G = gridDim.x; C.bx = blockIdx.x; C.vcu = C.bx;
    ParamsPtr pp0 = (ParamsPtr)__builtin_amdgcn_kernarg_segment_ptr();
    C.p = pp0; C.ws = pp0->ws;
    volatile LAS unsigned* MISC = (volatile LAS unsigned*)(C.lds + LDSCTL_OFF + 320);
    for (int u = C.tid; u < (LDS_BYTES - LDSCTL_OFF) / 4; u += NTHREADS) ((LAS unsigned*)(C.lds + LDSCTL_OFF))[u] = 0u;
    __syncthreads();
    const int lo = pp0->ph_lo, hi = pp0->ph_hi;
    XcdBarrier bar; bar.bar = (unsigned*)(C.ws + WS_CTL) + CW_BAR; bar.x = 0; bar.st = nullptr;
    if (hi - lo > 1) bar = xcd_barrier_post((unsigned*)(C.ws + WS_CTL) + CW_BAR, MISC + 8);
#ifdef TS_K1
    unsigned long long ts_acc1 = 0, ts_acc2 = 0;
#endif
    for (int ph = lo; ph < hi; ++ph) {
        ParamsPtr pp = (ParamsPtr)__builtin_amdgcn_kernarg_segment_ptr();
        asm volatile("" : "+s"(pp));
        C.p = pp; C.ws = pp->ws;
        { int t_ = threadIdx.x, g_ = gridDim.x, b_ = blockIdx.x; asm volatile("" : "+v"(t_), "+s"(g_), "+s"(b_));
          C.tid = t_; C.lane = t_ & 63; C.wave = __builtin_amdgcn_readfirstlane(t_ >> 6); C.G = g_; C.bx = b_; C.vcu = (g_ % 8 == 0) ? (b_ % 8) * (g_ / 8) + b_ / 8 : b_; }
#ifdef TS_K1
        const unsigned long long ts0_ = __builtin_amdgcn_s_memrealtime();
#endif
        run_phase(C, ph);
        if (ph + 1 < hi) xcd_barrier(bar);
#ifdef TS_K1
        { const unsigned long long ts1_ = __builtin_amdgcn_s_memrealtime(); const int ty = (ph == 0) ? 11 : (ph - 1) % 11;
          if (ty == TS_K1) ts_acc1 += ts1_ - ts0_; if (ty == TS_K2) ts_acc2 += ts1_ - ts0_; }
#endif
    }
#ifdef TS_K1
    if (blockIdx.x == 0 && threadIdx.x == 0) { asm volatile("s_waitcnt vmcnt(0)" ::: "memory"); float* o = pp0->out; o[0] += (float)ts_acc1 * 0.01f; o[1] += (float)ts_acc2 * 0.01f; }
#endif
}

#ifdef PROBE_STOP
__global__ void probe_dump_bf16(const bf16_t* src, int ld, float* out) {
    for (size_t e = (size_t)blockIdx.x * blockDim.x + threadIdx.x; e < (size_t)MMAIN * DM; e += (size_t)gridDim.x * blockDim.x) { const size_t r = e >> 10, c = e & 1023; out[e] = bf2f(src[r * ld + c]); }
}
#endif
extern "C" void kernel_launch(void* const* d_in, const int* in_sizes, int n_in, void* d_out, int out_size, void* d_ws, size_t ws_size, hipStream_t stream) {
    static int grid = 0;
    if (grid == 0) {
        if (n_in != 23 || out_size != MMAIN * DM || ws_size < WS_END) { fprintf(stderr, "kernel_launch: unexpected shapes (n_in %d out %d ws %zu)\n", n_in, out_size, ws_size); grid = -1; return; }
        int dev = 0, cus = 0, per_cu = 0;
        if (hipGetDevice(&dev) != hipSuccess || hipDeviceGetAttribute(&cus, hipDeviceAttributeMultiprocessorCount, dev) != hipSuccess) { grid = -1; return; }
        if (hipFuncSetAttribute((const void*)fwd_kernel, hipFuncAttributeMaxDynamicSharedMemorySize, LDS_BYTES) != hipSuccess) { fprintf(stderr, "kernel_launch: hipFuncSetAttribute failed\n"); grid = -1; return; }
        if (hipOccupancyMaxActiveBlocksPerMultiprocessor(&per_cu, (const void*)fwd_kernel, NTHREADS, LDS_BYTES) != hipSuccess || per_cu < 1) fprintf(stderr, "kernel_launch: occupancy query says %d\n", per_cu);
        (void)hipGetLastError();
        grid = cus;
    }
    if (grid < 0) return;
    (void)hipMemsetAsync((char*)d_ws + WS_CTL, 0, CTL_ZERO_BYTES, stream);
    Params p{};
    for (int i = 0; i < 23; ++i) p.in[i] = (const float*)d_in[i];
    p.out = (float*)d_out; p.ws = (unsigned char*)d_ws;
#ifndef N_LAUNCH_SPLIT
#define N_LAUNCH_SPLIT 0
#endif
#ifdef PROBE_STOP
    for (int ph = 0; ph <= PROBE_STOP; ++ph) { p.ph_lo = ph; p.ph_hi = ph + 1; hipLaunchKernelGGL(fwd_kernel, dim3(grid), dim3(NTHREADS), LDS_BYTES, stream, p); }
    hipLaunchKernelGGL(probe_dump_bf16, dim3(2048), dim3(256), 0, stream, (const bf16_t*)((unsigned char*)d_ws + PROBE_BUF), PROBE_LD, (float*)d_out);
    return;
#endif
    if (N_LAUNCH_SPLIT) { for (int ph = 0; ph < NPHASE; ++ph) { p.ph_lo = ph; p.ph_hi = ph + 1; hipLaunchKernelGGL(fwd_kernel, dim3(grid), dim3(NTHREADS), LDS_BYTES, stream, p); } }
    else { p.ph_lo = 0; p.ph_hi = NPHASE; hipLaunchKernelGGL(fwd_kernel, dim3(grid), dim3(NTHREADS), LDS_BYTES, stream, p); }
}
```
